# Optimizing an MI355X kernel written in HIP

```python
import jax, jax.numpy as jnp
from jax import lax
import numpy as np

D_MODEL = 1024
BATCH = 8
SEQ = 4096
DEPTH = 1

D_HEAD = 64
N_HEADS_TOTAL = D_MODEL // D_HEAD
D_MIX = N_HEADS_TOTAL * D_HEAD
N_HEADS_DSA = N_HEADS_TOTAL // 2
N_HEADS_FOX = N_HEADS_TOTAL - N_HEADS_DSA
N_IDX_HEADS = 4
D_IDX = 64
TOP_K_MAX = 256
ROPE_THETA = 500000.0
ROT_DIM = D_HEAD // 4
ROT_DIM_IDX = D_IDX // 4
D_FF = ((8 * D_MODEL // 3 + 255) // 256) * 256
BLOCK_Q_FOX = 128
BLOCK_Q_DSA = 64
N_MOD = 6
RMS_EPS = 1e-6

SPLIT_SIZES = (
    N_HEADS_DSA * D_HEAD,
    N_HEADS_DSA * D_HEAD,
    N_HEADS_DSA * D_HEAD,
    N_IDX_HEADS * D_IDX,
    D_IDX,
    N_IDX_HEADS,
    N_HEADS_FOX * D_HEAD,
    N_HEADS_FOX * D_HEAD,
    N_HEADS_FOX * D_HEAD,
    N_HEADS_FOX,
)
D_IN = int(sum(SPLIT_SIZES))
SPLIT_POINTS = [int(v) for v in np.cumsum(SPLIT_SIZES)[:-1]]

kernel_name = "hymba_dsa_fox_adaln_block"


def rms_norm(x, g):
    xf = x.astype(jnp.float32)
    y = xf * lax.rsqrt(jnp.mean(xf * xf, axis=-1, keepdims=True) + RMS_EPS)
    return (y * g.astype(jnp.float32)).astype(x.dtype)


def modulate(h, shift, scale):
    return h * (1 + scale[:, None, :]) + shift[:, None, :]


def split_heads(a, n):
    return a.reshape(a.shape[0], a.shape[1], n, -1)


def rope_partial(x, positions, rot_dim):
    half = rot_dim // 2
    inv_freq = ROPE_THETA ** (-jnp.arange(0, rot_dim, 2, dtype=jnp.float32) / rot_dim)
    ang = positions.astype(jnp.float32)[..., None] * inv_freq
    cos = jnp.cos(ang)[:, :, None, :]
    sin = jnp.sin(ang)[:, :, None, :]
    xf = x.astype(jnp.float32)
    x1, x2, rest = xf[..., :half], xf[..., half:rot_dim], xf[..., rot_dim:]
    out = jnp.concatenate([x1 * cos - x2 * sin, x2 * cos + x1 * sin, rest], axis=-1)
    return out.astype(x.dtype)


def to_blocks(a, bq):
    b, s = a.shape[0], a.shape[1]
    return a.reshape(b, s // bq, bq, *a.shape[2:]).swapaxes(0, 1)


def from_blocks(a):
    a = a.swapaxes(0, 1)
    return a.reshape(a.shape[0], a.shape[1] * a.shape[2], *a.shape[3:])


def dsa_attention(q, k, v, iq, ik, iw, k_top):
    s_len = q.shape[1]
    scale = D_HEAD ** -0.5
    idx_scale = D_IDX ** -0.5
    key_pos = jnp.arange(s_len)
    ik32 = ik.astype(jnp.float32)

    def one_block(args):
        qb, iqb, iwb, qpos = args
        dots = jnp.einsum('bqhd,bsd->bqhs', iqb.astype(jnp.float32), ik32) * idx_scale
        score = jnp.einsum('bqhs,bqh->bqs', jax.nn.relu(dots), iwb.astype(jnp.float32))
        causal = key_pos[None, :] <= qpos[:, None]
        score = jnp.where(causal[None], score, -jnp.inf)
        _, idx = lax.top_k(score, k_top)
        valid = idx <= qpos[None, :, None]
        k_sel = jax.vmap(lambda kk, ii: kk[ii])(k, idx)
        v_sel = jax.vmap(lambda vv, ii: vv[ii])(v, idx)
        logits = jnp.einsum('bqhd,bqkhd->bhqk', qb, k_sel).astype(jnp.float32) * scale
        logits = jnp.where(valid[:, None], logits, -jnp.inf)
        p = jax.nn.softmax(logits, axis=-1).astype(v.dtype)
        return jnp.einsum('bhqk,bqkhd->bqhd', p, v_sel)

    qpos = jnp.arange(s_len).reshape(s_len // BLOCK_Q_DSA, BLOCK_Q_DSA)
    out = lax.map(one_block, (to_blocks(q, BLOCK_Q_DSA), to_blocks(iq, BLOCK_Q_DSA),
                              to_blocks(iw, BLOCK_Q_DSA), qpos))
    return from_blocks(out)


def fox_attention(q, k, v, log_f):
    s_len = q.shape[1]
    scale = D_HEAD ** -0.5
    cum = jnp.cumsum(log_f, axis=1)
    cum_keys = cum.transpose(0, 2, 1)
    key_pos = jnp.arange(s_len)

    def one_block(args):
        qb, cq, qpos = args
        logits = jnp.einsum('bqhd,bshd->bhqs', qb, k).astype(jnp.float32) * scale
        bias = cq.transpose(0, 2, 1)[..., :, None] - cum_keys[..., None, :]
        causal = key_pos[None, :] <= qpos[:, None]
        logits = jnp.where(causal[None, None], logits + bias, -jnp.inf)
        p = jax.nn.softmax(logits, axis=-1).astype(v.dtype)
        return jnp.einsum('bhqs,bshd->bqhd', p, v)

    qpos = jnp.arange(s_len).reshape(s_len // BLOCK_Q_FOX, BLOCK_Q_FOX)
    out = lax.map(one_block, (to_blocks(q, BLOCK_Q_FOX), to_blocks(cum, BLOCK_Q_FOX), qpos))
    return from_blocks(out)


def hybrid_mixer(h, positions, w_in, b_forget, dsa_norm_g, fox_norm_g, w_out, k_top):
    b, s, _ = h.shape
    proj = h @ w_in
    q_d, k_d, v_d, iq, ik, iw, q_f, k_f, v_f, f_logit = jnp.split(proj, SPLIT_POINTS, axis=-1)
    q_d = rope_partial(split_heads(q_d, N_HEADS_DSA), positions, ROT_DIM)
    k_d = rope_partial(split_heads(k_d, N_HEADS_DSA), positions, ROT_DIM)
    v_d = split_heads(v_d, N_HEADS_DSA)
    iq = rope_partial(split_heads(iq, N_IDX_HEADS), positions, ROT_DIM_IDX)
    ik = rope_partial(ik[:, :, None, :], positions, ROT_DIM_IDX)[:, :, 0, :]
    iw = iw * (N_IDX_HEADS ** -0.5)
    o_d = dsa_attention(q_d, k_d, v_d, iq, ik, iw, k_top).reshape(b, s, -1)
    log_f = jax.nn.log_sigmoid((f_logit + b_forget).astype(jnp.float32))
    o_f = fox_attention(split_heads(q_f, N_HEADS_FOX), split_heads(k_f, N_HEADS_FOX),
                        split_heads(v_f, N_HEADS_FOX), log_f).reshape(b, s, -1)
    y = jnp.concatenate([rms_norm(o_d, dsa_norm_g), rms_norm(o_f, fox_norm_g)], axis=-1)
    return y @ w_out


def swiglu(h, w_gate, w_up, w_down):
    return (jax.nn.silu(h @ w_gate) * (h @ w_up)) @ w_down


def setup_inputs(seed: int = 0) -> dict:
    key = jax.random.key(seed)
    ks = jax.random.split(key, 16)
    f32 = jnp.float32
    nrm = lambda k, shape, s: jax.random.normal(k, shape, f32) * s
    x = jax.random.normal(ks[0], (BATCH, SEQ, D_MODEL), f32)
    c = jax.random.normal(ks[1], (BATCH, D_MODEL), f32)
    offset = jax.random.randint(ks[2], (BATCH, 1), 0, 1024, dtype=jnp.int32)
    positions = (offset + jnp.arange(SEQ, dtype=jnp.int32)[None, :]).astype(jnp.int32)
    return {
        "x": x,
        "c": c,
        "positions": positions,
        "ada_w": nrm(ks[3], (DEPTH, D_MODEL, N_MOD * D_MODEL), 0.5 * D_MODEL ** -0.5),
        "ada_b": nrm(ks[4], (DEPTH, N_MOD * D_MODEL), 0.02),
        "norm_attn_g": 1.0 + nrm(ks[5], (DEPTH, D_MODEL), 0.02),
        "w_in": nrm(ks[6], (DEPTH, D_MODEL, D_IN), D_MODEL ** -0.5),
        "b_forget": 2.0 + nrm(ks[7], (DEPTH, N_HEADS_FOX), 0.5),
        "dsa_norm_g": 1.0 + nrm(ks[8], (DEPTH, N_HEADS_DSA * D_HEAD), 0.02),
        "fox_norm_g": 1.0 + nrm(ks[9], (DEPTH, N_HEADS_FOX * D_HEAD), 0.02),
        "w_out": nrm(ks[10], (DEPTH, D_MIX, D_MODEL), D_MIX ** -0.5),
        "norm_ffn_g": 1.0 + nrm(ks[11], (DEPTH, D_MODEL), 0.02),
        "w_gate": nrm(ks[12], (DEPTH, D_MODEL, D_FF), D_MODEL ** -0.5),
        "w_up": nrm(ks[13], (DEPTH, D_MODEL, D_FF), D_MODEL ** -0.5),
        "w_down": nrm(ks[14], (DEPTH, D_FF, D_MODEL), D_FF ** -0.5),
        "final_norm_g": 1.0 + nrm(ks[15], (D_MODEL,), 0.02),
    }


def reference(x, c, positions, ada_w, ada_b, norm_attn_g, w_in, b_forget, dsa_norm_g,
              fox_norm_g, w_out, norm_ffn_g, w_gate, w_up, w_down, final_norm_g):
    s_len = x.shape[1]
    k_top = min(TOP_K_MAX, s_len // 4)
    c_act = jax.nn.silu(c)
    for l in range(DEPTH):
        mod = c_act @ ada_w[l] + ada_b[l]
        sh1, sc1, g1, sh2, sc2, g2 = jnp.split(mod, N_MOD, axis=-1)
        h = modulate(rms_norm(x, norm_attn_g[l]), sh1, sc1)
        x = x + g1[:, None, :] * hybrid_mixer(h, positions, w_in[l], b_forget[l], dsa_norm_g[l],
                                              fox_norm_g[l], w_out[l], k_top)
        h = modulate(rms_norm(x, norm_ffn_g[l]), sh2, sc2)
        x = x + g2[:, None, :] * swiglu(h, w_gate[l], w_up[l], w_down[l])
    return rms_norm(x, final_norm_g)
```

```cpp
#include <hip/hip_runtime.h>
#include <cstdio>
#include <cstdint>
#include <cmath>

constexpr int B_ = 8, S_ = 4096, D_ = 1024, M_ = B_ * S_, DIN = 3404, DFF = 2816, NMOD = 6144;
constexpr int C_QD = 0, C_KD = 512, C_VD = 1024, C_IQ = 1536, C_IK = 1792, C_IW = 1856, C_QF = 1860, C_KF = 2372, C_VF = 2884, C_FG = 3396;
constexpr float RMS_EPS = 1e-6f;

__device__ __forceinline__ float block_sum256(float v, float* red) {
    const int tid = threadIdx.x;
    red[tid] = v; __syncthreads();
    for (int o = 128; o > 0; o >>= 1) { if (tid < o) red[tid] += red[tid + o]; __syncthreads(); }
    const float r = red[0]; __syncthreads(); return r;
}
__device__ __forceinline__ float block_max256(float v, float* red) {
    const int tid = threadIdx.x;
    red[tid] = v; __syncthreads();
    for (int o = 128; o > 0; o >>= 1) { if (tid < o) red[tid] = fmaxf(red[tid], red[tid + o]); __syncthreads(); }
    const float r = red[0]; __syncthreads(); return r;
}

__global__ void __launch_bounds__(256) nk_mod(const float* c, const float* aw, const float* ab, float* mod) {
    __shared__ float ca[8][1024];
    const int tid = threadIdx.x, n = blockIdx.x * 256 + tid;
    for (int i = tid; i < 8192; i += 256) { const float v = c[i]; ca[i >> 10][i & 1023] = v / (1.f + expf(-v)); }
    __syncthreads();
    float acc[8];
#pragma unroll
    for (int b = 0; b < 8; ++b) acc[b] = 0.f;
    for (int k = 0; k < 1024; ++k) { const float w = aw[(size_t)k * NMOD + n];
#pragma unroll
        for (int b = 0; b < 8; ++b) acc[b] += ca[b][k] * w; }
#pragma unroll
    for (int b = 0; b < 8; ++b) mod[b * NMOD + n] = acc[b] + ab[n];
}

__global__ void __launch_bounds__(256) nk_norm_mod(const float* x, const float* g, const float* mod, int sh_off, int sc_off, float* out) {
    __shared__ float red[256];
    const int row = blockIdx.x, tid = threadIdx.x, b = row / S_;
    const float4 v = ((const float4*)(x + (size_t)row * D_))[tid];
    const float ss = block_sum256(v.x * v.x + v.y * v.y + v.z * v.z + v.w * v.w, red);
    const float rstd = 1.0f / sqrtf(ss * (1.0f / D_) + RMS_EPS);
    const float4 gg = ((const float4*)g)[tid];
    float4 o = {v.x * rstd * gg.x, v.y * rstd * gg.y, v.z * rstd * gg.z, v.w * rstd * gg.w};
    if (mod) {
        const float4 sc = ((const float4*)(mod + b * NMOD + sc_off))[tid], sh = ((const float4*)(mod + b * NMOD + sh_off))[tid];
        o.x = o.x * (1.f + sc.x) + sh.x; o.y = o.y * (1.f + sc.y) + sh.y; o.z = o.z * (1.f + sc.z) + sh.z; o.w = o.w * (1.f + sc.w) + sh.w;
    }
    ((float4*)(out + (size_t)row * D_))[tid] = o;
}

enum { EPI_PLAIN = 0, EPI_RES = 1, EPI_GATEUP = 2 };
struct GemmArgs { const float* A; int lda; const float* W; const float* W2; int ldw; int M, N, K; float* C; int ldc; const float* base; const float* mod; int g_off; };
template <int EPI> __global__ void __launch_bounds__(256) nk_gemm(GemmArgs a) {
    __shared__ float As[16][65];
    __shared__ float Ws[16][64];
    __shared__ float Ws2[EPI == EPI_GATEUP ? 16 : 1][64];
    const int tid = threadIdx.x, tx = tid & 15, ty = tid >> 4, m0 = blockIdx.y * 64, n0 = blockIdx.x * 64;
    float acc[4][4], acc2[4][4];
#pragma unroll
    for (int i = 0; i < 4; ++i)
#pragma unroll
        for (int j = 0; j < 4; ++j) { acc[i][j] = 0.f; acc2[i][j] = 0.f; }
    for (int k0 = 0; k0 < a.K; k0 += 16) {
#pragma unroll
        for (int i = 0; i < 4; ++i) { const int idx = tid + i * 256, r = idx >> 4, kk = idx & 15; As[kk][r] = a.A[(size_t)(m0 + r) * a.lda + k0 + kk]; }
#pragma unroll
        for (int i = 0; i < 4; ++i) { const int idx = tid + i * 256, kk = idx >> 6, c = idx & 63; const bool ok = (n0 + c) < a.N;
            Ws[kk][c] = ok ? a.W[(size_t)(k0 + kk) * a.ldw + n0 + c] : 0.f;
            if (EPI == EPI_GATEUP) Ws2[kk][c] = ok ? a.W2[(size_t)(k0 + kk) * a.ldw + n0 + c] : 0.f; }
        __syncthreads();
#pragma unroll
        for (int kk = 0; kk < 16; ++kk) {
            float av[4], bv[4], bv2[4];
#pragma unroll
            for (int i = 0; i < 4; ++i) av[i] = As[kk][ty * 4 + i];
#pragma unroll
            for (int j = 0; j < 4; ++j) { bv[j] = Ws[kk][tx * 4 + j]; if (EPI == EPI_GATEUP) bv2[j] = Ws2[kk][tx * 4 + j]; }
#pragma unroll
            for (int i = 0; i < 4; ++i)
#pragma unroll
                for (int j = 0; j < 4; ++j) { acc[i][j] += av[i] * bv[j]; if (EPI == EPI_GATEUP) acc2[i][j] += av[i] * bv2[j]; }
        }
        __syncthreads();
    }
#pragma unroll
    for (int i = 0; i < 4; ++i) { const int row = m0 + ty * 4 + i, b = row / S_;
#pragma unroll
        for (int j = 0; j < 4; ++j) { const int col = n0 + tx * 4 + j; if (col >= a.N) continue;
            float v = acc[i][j];
            if (EPI == EPI_RES) v = a.base[(size_t)row * a.ldc + col] + a.mod[b * NMOD + a.g_off + col] * v;
            if (EPI == EPI_GATEUP) { const float gq = v; v = gq / (1.f + expf(-gq)) * acc2[i][j]; }
            a.C[(size_t)row * a.ldc + col] = v; } }
}

__global__ void __launch_bounds__(192) nk_post_proj(float* proj, const int* positions, const float* bfg) {
    const int row = blockIdx.x, t = threadIdx.x; float* p = proj + (size_t)row * DIN;
    const int pos = positions[row];
    if (t < 168) { const int hh = t >> 3, i = t & 7;
        const int base = hh < 8 ? C_QD + hh * 64 : hh < 16 ? C_KD + (hh - 8) * 64 : hh < 20 ? C_IQ + (hh - 16) * 64 : C_IK;
        const float inv = (float)pow(500000.0, -(double)i / 8.0);
        const float angf = (float)pos * inv;
        const float c = (float)cos((double)angf), s = (float)sin((double)angf);
        const float x1 = p[base + i], x2 = p[base + 8 + i];
        p[base + i] = x1 * c - x2 * s; p[base + 8 + i] = x2 * c + x1 * s;
    } else if (t < 172) { p[C_IW + t - 168] *= 0.5f; }
    else if (t < 180) { const int h = t - 172; const float z = p[C_FG + h] + bfg[h]; p[C_FG + h] = fminf(z, 0.f) - log1pf(expf(-fabsf(z))); }
}

__global__ void __launch_bounds__(64) nk_cumsum(const float* proj, float* cum) {
    const int b = blockIdx.x >> 3, h = blockIdx.x & 7, l = threadIdx.x;
    const float* src = proj + (size_t)(b * S_ + 64 * l) * DIN + C_FG + h;
    double s = 0.0;
    for (int i = 0; i < 64; ++i) s += (double)src[(size_t)i * DIN];
    double incl = s;
    for (int o = 1; o < 64; o <<= 1) { const double v = __shfl_up(incl, o); if (l >= o) incl += v; }
    double run = incl - s;
    for (int i = 0; i < 64; ++i) { run += (double)src[(size_t)i * DIN]; cum[(size_t)(b * S_ + 64 * l + i) * 8 + h] = (float)run; }
}

__device__ __forceinline__ unsigned mono_key(float f) { const unsigned u = __float_as_uint(f); return (u & 0x80000000u) ? ~u : (u | 0x80000000u); }

__global__ void __launch_bounds__(256) nk_select(const float* proj, unsigned* mask) {
    __shared__ float iq[256]; __shared__ float iw[4]; __shared__ unsigned key[4096]; __shared__ unsigned hist[256]; __shared__ int sh_bin, sh_kk; __shared__ unsigned cnt[256]; __shared__ unsigned short half[256];
    const int t = blockIdx.x, b = blockIdx.y, tid = threadIdx.x, row = b * S_ + t, n = t + 1;
    unsigned* mrow = mask + (size_t)row * 128;
    if (n <= 256) { if (tid < 128) { const int lo = tid * 32; unsigned w = 0u; if (n >= lo + 32) w = 0xffffffffu; else if (n > lo) w = (1u << (n - lo)) - 1u; mrow[tid] = w; } return; }
    iq[tid] = proj[(size_t)row * DIN + C_IQ + tid]; if (tid < 4) iw[tid] = proj[(size_t)row * DIN + C_IW + tid];
    __syncthreads();
#pragma unroll 1
    for (int s = tid; s < n; s += 256) {
        asm volatile("" ::: "memory");
        const float4* kr = (const float4*)(proj + (size_t)(b * S_ + s) * DIN + C_IK);
        float d[4] = {0.f, 0.f, 0.f, 0.f};
#pragma unroll
        for (int j = 0; j < 16; ++j) { const float4 k4 = kr[j];
#pragma unroll
            for (int h = 0; h < 4; ++h) d[h] += iq[h * 64 + 4 * j] * k4.x + iq[h * 64 + 4 * j + 1] * k4.y + iq[h * 64 + 4 * j + 2] * k4.z + iq[h * 64 + 4 * j + 3] * k4.w; }
        float sc = 0.f;
#pragma unroll
        for (int h = 0; h < 4; ++h) sc += fmaxf(d[h] * 0.125f, 0.f) * iw[h];
        key[s] = mono_key(sc);
    }
    __syncthreads();
    unsigned prefix = 0u, pmask = 0u; int kk = 256;
    for (int shift = 24; shift >= 0; shift -= 8) {
        hist[tid] = 0u; __syncthreads();
        for (int s = tid; s < n; s += 256) { const unsigned k = key[s]; if ((k & pmask) == prefix) atomicAdd(&hist[(k >> shift) & 255u], 1u); }
        __syncthreads();
        if (tid == 0) { int c = 0, bin = 255; while (bin > 0 && c + (int)hist[bin] < kk) { c += (int)hist[bin]; --bin; } sh_bin = bin; sh_kk = kk - c; }
        __syncthreads();
        prefix |= (unsigned)sh_bin << shift; pmask |= 255u << shift; kk = sh_kk;
        __syncthreads();
    }
    unsigned ceq = 0u;
    for (int i = 0; i < 16; ++i) { const int s = tid * 16 + i; if (s < n && key[s] == prefix) ++ceq; }
    cnt[tid] = ceq; __syncthreads();
    unsigned before = 0u; for (int j = 0; j < tid; ++j) before += cnt[j];
    unsigned bits = 0u;
    for (int i = 0; i < 16; ++i) { const int s = tid * 16 + i; if (s < n) { const unsigned k = key[s];
        if (k > prefix) bits |= 1u << i; else if (k == prefix) { if ((int)before < kk) bits |= 1u << i; ++before; } } }
    half[tid] = (unsigned short)bits; __syncthreads();
    if (tid < 128) mrow[tid] = (unsigned)half[2 * tid] | ((unsigned)half[2 * tid + 1] << 16);
}

template <int MODE> __global__ void __launch_bounds__(256) nk_attn(const float* proj, int qoff, int koff, int voff, const float* cum, const unsigned* mask, float* o, int ooff) {
    __shared__ float lg[4096]; __shared__ float qs[64]; __shared__ float red[256];
    const int t = blockIdx.x, h = blockIdx.y, b = blockIdx.z, tid = threadIdx.x, row = b * S_ + t, n = t + 1;
    if (tid < 64) qs[tid] = proj[(size_t)row * DIN + qoff + h * 64 + tid];
    __syncthreads();
    const float cq = (MODE == 0) ? cum[(size_t)row * 8 + h] : 0.f;
    float mx = -INFINITY;
    for (int s = tid; s < n; s += 256) {
        const float4* kr = (const float4*)(proj + (size_t)(b * S_ + s) * DIN + koff + h * 64);
        float d = 0.f;
#pragma unroll
        for (int j = 0; j < 16; ++j) { const float4 k4 = kr[j]; d += qs[4 * j] * k4.x + qs[4 * j + 1] * k4.y + qs[4 * j + 2] * k4.z + qs[4 * j + 3] * k4.w; }
        d *= 0.125f;
        if (MODE == 0) d += cq - cum[(size_t)(b * S_ + s) * 8 + h];
        else { if (!((mask[(size_t)row * 128 + (s >> 5)] >> (s & 31)) & 1u)) d = -INFINITY; }
        lg[s] = d; mx = fmaxf(mx, d);
    }
    __syncthreads();
    mx = block_max256(mx, red);
    float sum = 0.f;
    for (int s = tid; s < n; s += 256) { const float p = expf(lg[s] - mx); lg[s] = p; sum += p; }
    __syncthreads();
    sum = block_sum256(sum, red);
    const int d = tid & 63, g = tid >> 6; float acc = 0.f;
    for (int s = g; s < n; s += 4) acc += lg[s] * proj[(size_t)(b * S_ + s) * DIN + voff + h * 64 + d];
    red[tid] = acc; __syncthreads();
    if (tid < 64) o[(size_t)row * D_ + ooff + h * 64 + tid] = (red[tid] + red[tid + 64] + red[tid + 128] + red[tid + 192]) / sum;
}

__global__ void __launch_bounds__(256) nk_group_norm(float* o, const float* gd, const float* gf) {
    __shared__ float red[256];
    const int row = blockIdx.x, tid = threadIdx.x, grp = tid >> 7, li = tid & 127;
    float4* p = (float4*)(o + (size_t)row * D_ + grp * 512) + li;
    const float4 v = *p;
    red[tid] = v.x * v.x + v.y * v.y + v.z * v.z + v.w * v.w; __syncthreads();
    for (int off = 64; off > 0; off >>= 1) { if (li < off) red[tid] += red[tid + off]; __syncthreads(); }
    const float rstd = 1.0f / sqrtf(red[grp * 128] * (1.0f / 512.f) + RMS_EPS);
    const float4 g = ((const float4*)(grp ? gf : gd))[li];
    *p = (float4){v.x * rstd * g.x, v.y * rstd * g.y, v.z * rstd * g.z, v.w * rstd * g.w};
}

extern "C" void kernel_launch(void* const* d_in, const int* in_sizes, int n_in, void* d_out, int out_size, void* d_ws, size_t ws_size, hipStream_t stream) {
    const float* x = (const float*)d_in[0]; const float* c = (const float*)d_in[1]; const int* positions = (const int*)d_in[2];
    const float* ada_w = (const float*)d_in[3]; const float* ada_b = (const float*)d_in[4]; const float* norm_attn_g = (const float*)d_in[5];
    const float* w_in = (const float*)d_in[6]; const float* b_forget = (const float*)d_in[7]; const float* dsa_g = (const float*)d_in[8]; const float* fox_g = (const float*)d_in[9];
    const float* w_out = (const float*)d_in[10]; const float* norm_ffn_g = (const float*)d_in[11]; const float* w_gate = (const float*)d_in[12]; const float* w_up = (const float*)d_in[13];
    const float* w_down = (const float*)d_in[14]; const float* final_g = (const float*)d_in[15];
    constexpr size_t MiB = 1u << 20;
    if (ws_size < 512 * MiB || n_in != 16 || out_size != M_ * D_) { fprintf(stderr, "kernel_launch: unexpected sizes ws %zu n_in %d out %d\n", ws_size, n_in, out_size); return; }
    unsigned char* ws = (unsigned char*)d_ws; float* out = (float*)d_out;
    float* mod = (float*)(ws); float* cum = (float*)(ws + 1 * MiB); unsigned* mask = (unsigned*)(ws + 2 * MiB);
    float* proj = (float*)(ws + 18 * MiB);
    float* hbuf = out;
    float* obuf = out;
    float* x1 = (float*)(ws + 18 * MiB);
    float* h2 = out;
    float* act = (float*)(ws + 146 * MiB);

    nk_mod<<<NMOD / 256, 256, 0, stream>>>(c, ada_w, ada_b, mod);
    nk_norm_mod<<<M_, 256, 0, stream>>>(x, norm_attn_g, mod, 0, 1024, hbuf);
    { GemmArgs a{hbuf, D_, w_in, nullptr, DIN, M_, DIN, D_, proj, DIN, nullptr, nullptr, 0};
      nk_gemm<EPI_PLAIN><<<dim3((DIN + 63) / 64, M_ / 64), 256, 0, stream>>>(a); }
    nk_post_proj<<<M_, 192, 0, stream>>>(proj, positions, b_forget);
    nk_cumsum<<<64, 64, 0, stream>>>(proj, cum);
    nk_select<<<dim3(S_, B_), 256, 0, stream>>>(proj, mask);
    nk_attn<1><<<dim3(S_, 8, B_), 256, 0, stream>>>(proj, C_QD, C_KD, C_VD, cum, mask, obuf, 0);
    nk_attn<0><<<dim3(S_, 8, B_), 256, 0, stream>>>(proj, C_QF, C_KF, C_VF, cum, mask, obuf, 512);
    nk_group_norm<<<M_, 256, 0, stream>>>(obuf, dsa_g, fox_g);
    { GemmArgs a{obuf, D_, w_out, nullptr, D_, M_, D_, D_, x1, D_, x, mod, 2048};
      nk_gemm<EPI_RES><<<dim3(D_ / 64, M_ / 64), 256, 0, stream>>>(a); }
    nk_norm_mod<<<M_, 256, 0, stream>>>(x1, norm_ffn_g, mod, 3072, 4096, h2);
    { GemmArgs a{h2, D_, w_gate, w_up, DFF, M_, DFF, D_, act, DFF, nullptr, nullptr, 0};
      nk_gemm<EPI_GATEUP><<<dim3(DFF / 64, M_ / 64), 256, 0, stream>>>(a); }
    { GemmArgs a{act, DFF, w_down, nullptr, D_, M_, D_, DFF, x1, D_, x1, mod, 5120};
      nk_gemm<EPI_RES><<<dim3(D_ / 64, M_ / 64), 256, 0, stream>>>(a); }
    nk_norm_mod<<<M_, 256, 0, stream>>>(x1, final_g, nullptr, 0, 0, out);
}
```

```cpp
#include <hip/hip_runtime.h>
#include <cstdio>
#include <cstdint>
#include <cmath>
#include <cstring>

constexpr int B_ = 8, S_ = 4096, D_ = 1024, M_ = B_ * S_, DIN = 3404, DFF = 2816, NMOD = 6144;
constexpr int C_QD = 0, C_KD = 512, C_VD = 1024, C_IQ = 1536, C_IK = 1792, C_IW = 1856, C_QF = 1860, C_KF = 2372, C_VF = 2884, C_FG = 3396;
constexpr float RMS_EPS = 1e-6f;

__device__ __forceinline__ float block_sum256(float v, float* red) {
    const int tid = threadIdx.x;
    red[tid] = v; __syncthreads();
    for (int o = 128; o > 0; o >>= 1) { if (tid < o) red[tid] += red[tid + o]; __syncthreads(); }
    const float r = red[0]; __syncthreads(); return r;
}
__device__ __forceinline__ float block_max256(float v, float* red) {
    const int tid = threadIdx.x;
    red[tid] = v; __syncthreads();
    for (int o = 128; o > 0; o >>= 1) { if (tid < o) red[tid] = fmaxf(red[tid], red[tid + o]); __syncthreads(); }
    const float r = red[0]; __syncthreads(); return r;
}

__global__ void __launch_bounds__(256) nk_mod(const float* c, const float* aw, const float* ab, float* mod) {
    __shared__ float ca[8][1024];
    const int tid = threadIdx.x, n = blockIdx.x * 256 + tid;
    for (int i = tid; i < 8192; i += 256) { const float v = c[i]; ca[i >> 10][i & 1023] = v / (1.f + expf(-v)); }
    __syncthreads();
    float acc[8];
#pragma unroll
    for (int b = 0; b < 8; ++b) acc[b] = 0.f;
    for (int k = 0; k < 1024; ++k) { const float w = aw[(size_t)k * NMOD + n];
#pragma unroll
        for (int b = 0; b < 8; ++b) acc[b] += ca[b][k] * w; }
#pragma unroll
    for (int b = 0; b < 8; ++b) mod[b * NMOD + n] = acc[b] + ab[n];
}

__global__ void __launch_bounds__(256) nk_norm_mod(const float* x, const float* g, const float* mod, int sh_off, int sc_off, float* out) {
    __shared__ float red[256];
    const int row = blockIdx.x, tid = threadIdx.x, b = row / S_;
    const float4 v = ((const float4*)(x + (size_t)row * D_))[tid];
    const float ss = block_sum256(v.x * v.x + v.y * v.y + v.z * v.z + v.w * v.w, red);
    const float rstd = 1.0f / sqrtf(ss * (1.0f / D_) + RMS_EPS);
    const float4 gg = ((const float4*)g)[tid];
    float4 o = {v.x * rstd * gg.x, v.y * rstd * gg.y, v.z * rstd * gg.z, v.w * rstd * gg.w};
    if (mod) {
        const float4 sc = ((const float4*)(mod + b * NMOD + sc_off))[tid], sh = ((const float4*)(mod + b * NMOD + sh_off))[tid];
        o.x = o.x * (1.f + sc.x) + sh.x; o.y = o.y * (1.f + sc.y) + sh.y; o.z = o.z * (1.f + sc.z) + sh.z; o.w = o.w * (1.f + sc.w) + sh.w;
    }
    ((float4*)(out + (size_t)row * D_))[tid] = o;
}

enum { EPI_PLAIN = 0, EPI_RES = 1, EPI_GATEUP = 2 };
struct GemmArgs { const float* A; const float* W; const float* W2; float* C; const float* base; const float* mod; int lda, ldw, M, N, K, ldc, g_off, pad; };
static GemmArgs mk_gemm(const float* A, int lda, const float* W, const float* W2, int ldw, int M, int N, int K, float* C, int ldc, const float* base, const float* mod, int g_off) {
    GemmArgs g; memset(&g, 0, sizeof(g)); g.A = A; g.W = W; g.W2 = W2; g.C = C; g.base = base; g.mod = mod; g.lda = lda; g.ldw = ldw; g.M = M; g.N = N; g.K = K; g.ldc = ldc; g.g_off = g_off; g.pad = 0; return g; }
template <int EPI> __global__ void __launch_bounds__(256) nk_gemm(GemmArgs a) {
    __shared__ float As[16][65];
    __shared__ float Ws[16][64];
    __shared__ float Ws2[EPI == EPI_GATEUP ? 16 : 1][64];
    const int tid = threadIdx.x, tx = tid & 15, ty = tid >> 4, m0 = blockIdx.y * 64, n0 = blockIdx.x * 64;
    float acc[4][4], acc2[4][4];
#pragma unroll
    for (int i = 0; i < 4; ++i)
#pragma unroll
        for (int j = 0; j < 4; ++j) { acc[i][j] = 0.f; acc2[i][j] = 0.f; }
    for (int k0 = 0; k0 < a.K; k0 += 16) {
#pragma unroll
        for (int i = 0; i < 4; ++i) { const int idx = tid + i * 256, r = idx >> 4, kk = idx & 15; As[kk][r] = a.A[(size_t)(m0 + r) * a.lda + k0 + kk]; }
#pragma unroll
        for (int i = 0; i < 4; ++i) { const int idx = tid + i * 256, kk = idx >> 6, c = idx & 63; const bool ok = (n0 + c) < a.N;
            Ws[kk][c] = ok ? a.W[(size_t)(k0 + kk) * a.ldw + n0 + c] : 0.f;
            if (EPI == EPI_GATEUP) Ws2[kk][c] = ok ? a.W2[(size_t)(k0 + kk) * a.ldw + n0 + c] : 0.f; }
        __syncthreads();
#pragma unroll
        for (int kk = 0; kk < 16; ++kk) {
            float av[4], bv[4], bv2[4];
#pragma unroll
            for (int i = 0; i < 4; ++i) av[i] = As[kk][ty * 4 + i];
#pragma unroll
            for (int j = 0; j < 4; ++j) { bv[j] = Ws[kk][tx * 4 + j]; if (EPI == EPI_GATEUP) bv2[j] = Ws2[kk][tx * 4 + j]; }
#pragma unroll
            for (int i = 0; i < 4; ++i)
#pragma unroll
                for (int j = 0; j < 4; ++j) { acc[i][j] += av[i] * bv[j]; if (EPI == EPI_GATEUP) acc2[i][j] += av[i] * bv2[j]; }
        }
        __syncthreads();
    }
#pragma unroll
    for (int i = 0; i < 4; ++i) { const int row = m0 + ty * 4 + i, b = row / S_;
#pragma unroll
        for (int j = 0; j < 4; ++j) { const int col = n0 + tx * 4 + j; if (col >= a.N) continue;
            float v = acc[i][j];
            if (EPI == EPI_RES) v = a.base[(size_t)row * a.ldc + col] + a.mod[b * NMOD + a.g_off + col] * v;
            if (EPI == EPI_GATEUP) { const float gq = v; v = gq / (1.f + expf(-gq)) * acc2[i][j]; }
            a.C[(size_t)row * a.ldc + col] = v; } }
}

__global__ void __launch_bounds__(192) nk_post_proj(float* proj, const int* positions, const float* bfg) {
    const int row = blockIdx.x, t = threadIdx.x; float* p = proj + (size_t)row * DIN;
    const int pos = positions[row];
    if (t < 168) { const int hh = t >> 3, i = t & 7;
        const int base = hh < 8 ? C_QD + hh * 64 : hh < 16 ? C_KD + (hh - 8) * 64 : hh < 20 ? C_IQ + (hh - 16) * 64 : C_IK;
        const float inv = (float)pow(500000.0, -(double)i / 8.0);
        const float angf = (float)pos * inv;
        const float c = (float)cos((double)angf), s = (float)sin((double)angf);
        const float x1 = p[base + i], x2 = p[base + 8 + i];
        p[base + i] = x1 * c - x2 * s; p[base + 8 + i] = x2 * c + x1 * s;
    } else if (t < 172) { p[C_IW + t - 168] *= 0.5f; }
    else if (t < 180) { const int h = t - 172; const float z = p[C_FG + h] + bfg[h]; p[C_FG + h] = fminf(z, 0.f) - log1pf(expf(-fabsf(z))); }
}

__global__ void __launch_bounds__(64) nk_cumsum(const float* proj, float* cum) {
    const int b = blockIdx.x >> 3, h = blockIdx.x & 7, l = threadIdx.x;
    const float* src = proj + (size_t)(b * S_ + 64 * l) * DIN + C_FG + h;
    double s = 0.0;
    for (int i = 0; i < 64; ++i) s += (double)src[(size_t)i * DIN];
    double incl = s;
    for (int o = 1; o < 64; o <<= 1) { const double v = __shfl_up(incl, o); if (l >= o) incl += v; }
    double run = incl - s;
    for (int i = 0; i < 64; ++i) { run += (double)src[(size_t)i * DIN]; cum[(size_t)(b * S_ + 64 * l + i) * 8 + h] = (float)run; }
}

__device__ __forceinline__ unsigned mono_key(float f) { const unsigned u = __float_as_uint(f); return (u & 0x80000000u) ? ~u : (u | 0x80000000u); }

__global__ void __launch_bounds__(256) nk_select(const float* proj, unsigned* mask) {
    __shared__ float iq[256]; __shared__ float iw[4]; __shared__ unsigned key[4096]; __shared__ unsigned hist[256]; __shared__ int sh_bin, sh_kk; __shared__ unsigned cnt[256]; __shared__ unsigned short half[256];
    const int t = blockIdx.x, b = blockIdx.y, tid = threadIdx.x, row = b * S_ + t, n = t + 1;
    unsigned* mrow = mask + (size_t)row * 128;
    if (n <= 256) { if (tid < 128) { const int lo = tid * 32; unsigned w = 0u; if (n >= lo + 32) w = 0xffffffffu; else if (n > lo) w = (1u << (n - lo)) - 1u; mrow[tid] = w; } return; }
    iq[tid] = proj[(size_t)row * DIN + C_IQ + tid]; if (tid < 4) iw[tid] = proj[(size_t)row * DIN + C_IW + tid];
    __syncthreads();
#pragma unroll 1
    for (int s = tid; s < n; s += 256) {
        asm volatile("" ::: "memory");
        const float4* kr = (const float4*)(proj + (size_t)(b * S_ + s) * DIN + C_IK);
        float d[4] = {0.f, 0.f, 0.f, 0.f};
#pragma unroll
        for (int j = 0; j < 16; ++j) { const float4 k4 = kr[j];
#pragma unroll
            for (int h = 0; h < 4; ++h) d[h] += iq[h * 64 + 4 * j] * k4.x + iq[h * 64 + 4 * j + 1] * k4.y + iq[h * 64 + 4 * j + 2] * k4.z + iq[h * 64 + 4 * j + 3] * k4.w; }
        float sc = 0.f;
#pragma unroll
        for (int h = 0; h < 4; ++h) sc += fmaxf(d[h] * 0.125f, 0.f) * iw[h];
        key[s] = mono_key(sc);
    }
    __syncthreads();
    unsigned prefix = 0u, pmask = 0u; int kk = 256;
    for (int shift = 24; shift >= 0; shift -= 8) {
        hist[tid] = 0u; __syncthreads();
        for (int s = tid; s < n; s += 256) { const unsigned k = key[s]; if ((k & pmask) == prefix) atomicAdd(&hist[(k >> shift) & 255u], 1u); }
        __syncthreads();
        if (tid == 0) { int c = 0, bin = 255; while (bin > 0 && c + (int)hist[bin] < kk) { c += (int)hist[bin]; --bin; } sh_bin = bin; sh_kk = kk - c; }
        __syncthreads();
        prefix |= (unsigned)sh_bin << shift; pmask |= 255u << shift; kk = sh_kk;
        __syncthreads();
    }
    unsigned ceq = 0u;
    for (int i = 0; i < 16; ++i) { const int s = tid * 16 + i; if (s < n && key[s] == prefix) ++ceq; }
    cnt[tid] = ceq; __syncthreads();
    unsigned before = 0u; for (int j = 0; j < tid; ++j) before += cnt[j];
    unsigned bits = 0u;
    for (int i = 0; i < 16; ++i) { const int s = tid * 16 + i; if (s < n) { const unsigned k = key[s];
        if (k > prefix) bits |= 1u << i; else if (k == prefix) { if ((int)before < kk) bits |= 1u << i; ++before; } } }
    half[tid] = (unsigned short)bits; __syncthreads();
    if (tid < 128) mrow[tid] = (unsigned)half[2 * tid] | ((unsigned)half[2 * tid + 1] << 16);
}

template <int MODE> __global__ void __launch_bounds__(256) nk_attn(const float* proj, int qoff, int koff, int voff, const float* cum, const unsigned* mask, float* o, int ooff) {
    __shared__ float lg[4096]; __shared__ float qs[64]; __shared__ float red[256];
    const int t = blockIdx.x, h = blockIdx.y, b = blockIdx.z, tid = threadIdx.x, row = b * S_ + t, n = t + 1;
    if (tid < 64) qs[tid] = proj[(size_t)row * DIN + qoff + h * 64 + tid];
    __syncthreads();
    const float cq = (MODE == 0) ? cum[(size_t)row * 8 + h] : 0.f;
    float mx = -INFINITY;
    for (int s = tid; s < n; s += 256) {
        const float4* kr = (const float4*)(proj + (size_t)(b * S_ + s) * DIN + koff + h * 64);
        float d = 0.f;
#pragma unroll
        for (int j = 0; j < 16; ++j) { const float4 k4 = kr[j]; d += qs[4 * j] * k4.x + qs[4 * j + 1] * k4.y + qs[4 * j + 2] * k4.z + qs[4 * j + 3] * k4.w; }
        d *= 0.125f;
        if (MODE == 0) d += cq - cum[(size_t)(b * S_ + s) * 8 + h];
        else { if (!((mask[(size_t)row * 128 + (s >> 5)] >> (s & 31)) & 1u)) d = -INFINITY; }
        lg[s] = d; mx = fmaxf(mx, d);
    }
    __syncthreads();
    mx = block_max256(mx, red);
    float sum = 0.f;
    for (int s = tid; s < n; s += 256) { const float p = expf(lg[s] - mx); lg[s] = p; sum += p; }
    __syncthreads();
    sum = block_sum256(sum, red);
    const int d = tid & 63, g = tid >> 6; float acc = 0.f;
    for (int s = g; s < n; s += 4) acc += lg[s] * proj[(size_t)(b * S_ + s) * DIN + voff + h * 64 + d];
    red[tid] = acc; __syncthreads();
    if (tid < 64) o[(size_t)row * D_ + ooff + h * 64 + tid] = (red[tid] + red[tid + 64] + red[tid + 128] + red[tid + 192]) / sum;
}

__global__ void __launch_bounds__(256) nk_group_norm(float* o, const float* gd, const float* gf) {
    __shared__ float red[256];
    const int row = blockIdx.x, tid = threadIdx.x, grp = tid >> 7, li = tid & 127;
    float4* p = (float4*)(o + (size_t)row * D_ + grp * 512) + li;
    const float4 v = *p;
    red[tid] = v.x * v.x + v.y * v.y + v.z * v.z + v.w * v.w; __syncthreads();
    for (int off = 64; off > 0; off >>= 1) { if (li < off) red[tid] += red[tid + off]; __syncthreads(); }
    const float rstd = 1.0f / sqrtf(red[grp * 128] * (1.0f / 512.f) + RMS_EPS);
    const float4 g = ((const float4*)(grp ? gf : gd))[li];
    *p = (float4){v.x * rstd * g.x, v.y * rstd * g.y, v.z * rstd * g.z, v.w * rstd * g.w};
}

namespace pg8 {
#define PG8_LAS __attribute__((address_space(3)))
typedef unsigned short bf16_t;
typedef _Float16 bf16x8 __attribute__((ext_vector_type(8)));
typedef float f32x4 __attribute__((ext_vector_type(4)));
typedef unsigned u32x4 __attribute__((ext_vector_type(4)));
constexpr int BM = 256, BK = 64, HALF = 128, HTB = HALF * BK * 2  , STAGE_BYTES = 8 * HTB, NXCD = 8, WGM = 8;

__host__ __device__ __forceinline__ int lds_byte(int r, int c) { const int st = (r >> 4) * 2 + (c >> 5), rr = r & 15, cc = c & 31, ob = rr * 64 + cc * 2; return st * 1024 + (ob ^ (((ob >> 9) & 1) << 5)); }
__host__ __device__ __forceinline__ void stage_rc(int b, int& R, int& C) { const int st = b / 1024, sb = b % 1024, swz = sb ^ (((sb >> 9) & 1) << 5); R = (st >> 1) * 16 + swz / 64; C = (st & 1) * 32 + (swz % 64) / 2; }
__host__ __device__ __forceinline__ int perm32(int rho) { const int n = rho >> 4, i = rho & 15; return 8 * (i >> 2) + 4 * n + (i & 3); }

struct Unit { int pm, pn; };
struct Gemm { const bf16_t* A; const bf16_t* Bt; int M, N, K; };

struct StaticOrder {
    int nM, nN, nwg, G, c;
    __host__ __device__ void init(int M, int N, int G_, int c_) { nM = M / BM; nN = N / BM; nwg = nM * nN; G = G_; c = c_; }
    __host__ __device__ bool next(int i, Unit& u) const {
        const long L = (long)i * G + c; if (L >= nwg) return false;
        int wgid = (int)L; { const int q = nwg / NXCD, r = nwg % NXCD, xcd = wgid % NXCD, off = wgid / NXCD; wgid = (xcd < r ? xcd * (q + 1) : r * (q + 1) + (xcd - r) * q) + off; }
        const int nig = WGM * nN, gid = wgid / nig, fm = gid * WGM, gsz = (nM - fm) < WGM ? (nM - fm) : WGM;
        u.pm = fm + ((wgid % nig) % gsz); u.pn = (wgid % nig) / gsz; return true;
    }
    __device__ __forceinline__ void a_ready(const Unit&) const {}
    __device__ __forceinline__ void done(const Unit&) const {}
};

__device__ __forceinline__ unsigned cvt_pk_f16(float lo, float hi) { typedef float f2_ __attribute__((ext_vector_type(2))); typedef _Float16 h2_ __attribute__((ext_vector_type(2))); f2_ v = {lo, hi}; h2_ h = __builtin_convertvector(v, h2_); return __builtin_bit_cast(unsigned, h); }
template <class Epi, class Sched, bool ALIGN_EPI = false, bool SP2 = false>
__device__ __forceinline__ void gemm_phase(PG8_LAS unsigned char* lds, const Gemm g, const Sched& S, const Epi& E) {
    const int tid = threadIdx.x, wid = __builtin_amdgcn_readfirstlane(tid >> 6), lane = tid & 63, wr = wid >> 2, wc = wid & 3, fr = lane & 15, fq = lane >> 4;
    const int K = g.K, nt = K / BK;
    unsigned voffA[2], voffB[2];
#pragma unroll
    for (int i = 0; i < 2; ++i) { int R, C; stage_rc(tid * 16 + i * 8192, R, C); const int Rb = Epi::PERM ? ((R & ~31) + perm32(R & 31)) : R;
        voffA[i] = (unsigned)(R * K + C) * 2u; voffB[i] = (unsigned)(Rb * K + C) * 2u; }
    const size_t kstep = (size_t)(BK * 2);
    const size_t hstep = (size_t)HALF * K * 2;
    const size_t tstep = 2 * hstep;
    const unsigned ldsw = (unsigned)wid * 1024u;
    const int aoff = lds_byte(wr * 64 + fr, fq * 8), boff = lds_byte(wc * 32 + fr, fq * 8);
#define PG8_SA(b, h) (((b) * 2 + (h)) * HTB)
#define PG8_SB(b, h) ((4 + (b) * 2 + (h)) * HTB)
#define PG8_STAGE(bufoff, gbase, voff) do { _Pragma("unroll") for (int _i = 0; _i < 2; ++_i) \
        __builtin_amdgcn_global_load_lds((const unsigned*)((const char*)(gbase) + (voff)[_i]), (PG8_LAS unsigned*)(lds + (bufoff) + ldsw + _i * 8192), 16, 0, 0); } while (0)
#define PG8_LDA(dst, b, h) do { _Pragma("unroll") for (int m = 0; m < 4; ++m) _Pragma("unroll") for (int k = 0; k < 2; ++k) dst[m][k] = *(const PG8_LAS bf16x8*)(lds + PG8_SA(b, h) + aoff + m * 2048 + k * 1024); } while (0)
#define PG8_LDB(dst, b, h) do { _Pragma("unroll") for (int n = 0; n < 2; ++n) _Pragma("unroll") for (int k = 0; k < 2; ++k) dst[n][k] = *(const PG8_LAS bf16x8*)(lds + PG8_SB(b, h) + boff + n * 2048 + k * 1024); } while (0)
#define PG8_MMA(ai, bj, At, Bt) do { __builtin_amdgcn_s_setprio(1); _Pragma("unroll") for (int m = 0; m < 4; ++m) _Pragma("unroll") for (int n = 0; n < 2; ++n) _Pragma("unroll") for (int k = 0; k < 2; ++k) \
        acc[ai][bj][m][n] = __builtin_amdgcn_mfma_f32_16x16x32_f16(Bt[n][k], At[m][k], acc[ai][bj][m][n], 0, 0, 0); __builtin_amdgcn_s_setprio(0); } while (0)
#define PG8_WAIT_V(n) asm volatile("s_waitcnt vmcnt(" #n ")" ::: "memory")
#define PG8_WAIT_L(n) asm volatile("s_waitcnt lgkmcnt(" #n ")" ::: "memory")
#define PG8_BAR __builtin_amdgcn_s_barrier()
#define PG8_SCHED __builtin_amdgcn_sched_barrier(0)
    Unit cur, nxt; int ui = 0;
    if (!S.next(0, cur)) return;
    f32x4 acc[2][2][4][2];
#pragma unroll
    for (int a = 0; a < 2; ++a)
#pragma unroll
        for (int b = 0; b < 2; ++b)
#pragma unroll
            for (int m = 0; m < 4; ++m)
#pragma unroll
                for (int n = 0; n < 2; ++n) acc[a][b][m][n] = (f32x4){0.f, 0.f, 0.f, 0.f};
    bf16x8 At[4][2], B0[2][2], B1[2][2];
    const char* cA = (const char*)g.A + (size_t)cur.pm * tstep; const char* cB = (const char*)g.Bt + (size_t)cur.pn * tstep;
    S.a_ready(cur);
    if constexpr (SP2) {
        PG8_STAGE(PG8_SB(0, 0), cB, voffB); PG8_STAGE(PG8_SB(0, 1), cB + hstep, voffB); PG8_STAGE(PG8_SA(0, 0), cA, voffA); PG8_STAGE(PG8_SA(0, 1), cA + hstep, voffA);
        if (wr == 1) PG8_BAR;
        PG8_WAIT_V(2); PG8_BAR;
        PG8_STAGE(PG8_SB(1, 0), cB + kstep, voffB); PG8_STAGE(PG8_SA(1, 0), cA + kstep, voffA); PG8_STAGE(PG8_SB(1, 1), cB + hstep + kstep, voffB);
        PG8_WAIT_V(6); PG8_BAR;
    } else {
        PG8_STAGE(PG8_SB(0, 0), cB, voffB); PG8_STAGE(PG8_SA(0, 0), cA, voffA); PG8_STAGE(PG8_SB(0, 1), cB + hstep, voffB); PG8_STAGE(PG8_SA(0, 1), cA + hstep, voffA);
        if (wr == 1) PG8_BAR;
        PG8_WAIT_V(4); PG8_BAR;
        PG8_STAGE(PG8_SB(1, 0), cB + kstep, voffB); PG8_STAGE(PG8_SA(1, 0), cA + kstep, voffA); PG8_STAGE(PG8_SB(1, 1), cB + hstep + kstep, voffB);
        PG8_WAIT_V(6); PG8_BAR;
    }
    for (;;) {
        const bool has_next = S.next(ui + 1, nxt);
        const char* nA = has_next ? (const char*)g.A + (size_t)nxt.pm * tstep : cA; const char* nB = has_next ? (const char*)g.Bt + (size_t)nxt.pn * tstep : cB;
        for (int t = 0; t < nt; t += 2) {
            const bool last = (t == nt - 2);
            const char* a1 = cA + (size_t)(t + 1) * kstep;
            const char* a2 = last ? nA : cA + (size_t)(t + 2) * kstep; const char* b2 = last ? nB : cB + (size_t)(t + 2) * kstep;
            const char* a3 = a2 + kstep; const char* b3 = b2 + kstep;
            if (last && has_next) S.a_ready(nxt);
            if constexpr (SP2) {
            PG8_LDB(B0, 0, 0); PG8_LDB(B1, 0, 1); PG8_SCHED; PG8_LDA(At, 0, 0); PG8_STAGE(PG8_SA(1, 1), a1 + hstep, voffA);
            PG8_WAIT_V(8); PG8_WAIT_L(0); PG8_BAR; PG8_MMA(0, 0, At, B0); PG8_MMA(0, 1, At, B1); PG8_BAR; PG8_SCHED;
            PG8_LDA(At, 0, 1); PG8_STAGE(PG8_SB(0, 0), b2, voffB); PG8_STAGE(PG8_SB(0, 1), b2 + hstep, voffB); PG8_STAGE(PG8_SA(0, 0), a2, voffA);
            PG8_WAIT_V(8); PG8_WAIT_L(0); PG8_BAR; PG8_MMA(1, 0, At, B0); PG8_MMA(1, 1, At, B1); PG8_BAR; PG8_SCHED;
            PG8_LDB(B0, 1, 0); PG8_LDB(B1, 1, 1); PG8_SCHED; PG8_LDA(At, 1, 0); PG8_STAGE(PG8_SA(0, 1), a2 + hstep, voffA);
            PG8_WAIT_V(8); PG8_WAIT_L(0); PG8_BAR; PG8_MMA(0, 0, At, B0); PG8_MMA(0, 1, At, B1); PG8_BAR; PG8_SCHED;
            PG8_LDA(At, 1, 1); PG8_STAGE(PG8_SB(1, 0), b3, voffB); PG8_STAGE(PG8_SB(1, 1), b3 + hstep, voffB); PG8_STAGE(PG8_SA(1, 0), a3, voffA);
            PG8_WAIT_V(8); PG8_WAIT_L(0); PG8_BAR; PG8_MMA(1, 0, At, B0); PG8_MMA(1, 1, At, B1); PG8_BAR; PG8_SCHED;
            } else {
            PG8_LDB(B0, 0, 0); PG8_SCHED; PG8_LDA(At, 0, 0); PG8_STAGE(PG8_SA(1, 1), a1 + hstep, voffA);
            PG8_WAIT_L(8); PG8_BAR; PG8_WAIT_L(0); PG8_MMA(0, 0, At, B0); PG8_BAR; PG8_SCHED;
            PG8_LDB(B1, 0, 1); PG8_STAGE(PG8_SB(0, 0), b2, voffB);
            PG8_BAR; PG8_WAIT_L(0); PG8_MMA(0, 1, At, B1); PG8_BAR;
            PG8_LDA(At, 0, 1); PG8_STAGE(PG8_SA(0, 0), a2, voffA);
            PG8_BAR; PG8_WAIT_L(0); PG8_MMA(1, 0, At, B0); PG8_BAR; PG8_SCHED;
            PG8_STAGE(PG8_SB(0, 1), b2 + hstep, voffB);
            PG8_WAIT_V(6); PG8_BAR; PG8_MMA(1, 1, At, B1); PG8_BAR;
            PG8_LDB(B0, 1, 0); PG8_SCHED; PG8_LDA(At, 1, 0); PG8_STAGE(PG8_SA(0, 1), a2 + hstep, voffA);
            PG8_WAIT_L(8); PG8_BAR; PG8_WAIT_L(0); PG8_MMA(0, 0, At, B0); PG8_BAR; PG8_SCHED;
            PG8_LDB(B1, 1, 1); PG8_STAGE(PG8_SB(1, 0), b3, voffB);
            PG8_BAR; PG8_WAIT_L(0); PG8_MMA(0, 1, At, B1); PG8_BAR;
            PG8_LDA(At, 1, 1); PG8_STAGE(PG8_SA(1, 0), a3, voffA);
            PG8_BAR; PG8_WAIT_L(0); PG8_MMA(1, 0, At, B0); PG8_BAR; PG8_SCHED;
            PG8_STAGE(PG8_SB(1, 1), b3 + hstep, voffB);
            PG8_WAIT_V(6); PG8_BAR; PG8_MMA(1, 1, At, B1); PG8_BAR;
            }
        }
        if constexpr (ALIGN_EPI) { if (wr == 0) PG8_BAR; }
        if constexpr (!Epi::AFTER_DRAIN) { E(acc, cur, wr, wc, fr, fq); S.done(cur); }
        if (!has_next) break;
#pragma unroll
        for (int a = 0; a < 2; ++a)
#pragma unroll
            for (int b = 0; b < 2; ++b)
#pragma unroll
                for (int m = 0; m < 4; ++m)
#pragma unroll
                    for (int n = 0; n < 2; ++n) acc[a][b][m][n] = (f32x4){0.f, 0.f, 0.f, 0.f};
        cur = nxt; cA = nA; cB = nB; ++ui;
        if constexpr (ALIGN_EPI) { if (wr == 1) PG8_BAR; }
    }
    PG8_WAIT_V(0);
    if constexpr (!ALIGN_EPI) { if (wr == 0) PG8_BAR; }
    PG8_BAR;
    if constexpr (Epi::AFTER_DRAIN) { E.fused(acc, cur, wr, wc, fr, fq, lds, wid, lane); S.done(cur); }
#undef PG8_SA
#undef PG8_SB
#undef PG8_STAGE
#undef PG8_LDA
#undef PG8_LDB
#undef PG8_MMA
#undef PG8_WAIT_V
#undef PG8_WAIT_L
#undef PG8_BAR
#undef PG8_SCHED
}
}
#define GAS __attribute__((address_space(1)))
#define LAS __attribute__((address_space(3)))
typedef _Float16 f16;
typedef unsigned v4u __attribute__((ext_vector_type(4)));
typedef unsigned v2u __attribute__((ext_vector_type(2)));
typedef float f32x4 __attribute__((ext_vector_type(4)));
typedef float f32x2 __attribute__((ext_vector_type(2)));
typedef GAS unsigned gu32;
typedef GAS unsigned long long gu64;
#define RLX_AGENT __ATOMIC_RELAXED, __HIP_MEMORY_SCOPE_AGENT
#define LDS_WAIT() asm volatile("s_waitcnt lgkmcnt(0)" ::: "memory")
#define VM_WAIT() asm volatile("s_waitcnt vmcnt(0)" ::: "memory")
__device__ __forceinline__ unsigned pkh(float lo, float hi) { typedef _Float16 h2_ __attribute__((ext_vector_type(2))); f32x2 v = {lo, hi}; h2_ h = __builtin_convertvector(v, h2_); return __builtin_bit_cast(unsigned, h); }
#define XB_TMO      128
#define XB_XCNT(j)  (256  + 64 * (j))
#define XB_XSUB(j)  (1280 + 64 * (j))
#define XB_XGEN(j)  (2304 + 64 * (j))
#define XB_TOP      3328
#define XB_TOPGEN   3392
#define XCD_BAR_WORDS 3456
#define XB_SPIN_CAP (1u << 18)

__device__ __forceinline__ unsigned xb_ld(unsigned* p)              { return __hip_atomic_load(p, __ATOMIC_RELAXED, __HIP_MEMORY_SCOPE_AGENT); }
__device__ __forceinline__ unsigned xb_add(unsigned* p, unsigned v) { return __hip_atomic_fetch_add(p, v, __ATOMIC_RELAXED, __HIP_MEMORY_SCOPE_AGENT); }
__device__ __forceinline__ unsigned xb_xcc_id() { return (unsigned)__builtin_amdgcn_s_getreg((3 << 11) | 20) & 0xFu; }
#define XB_SPIN(cond, bar) do { unsigned _sp = 0; while (cond) { __builtin_amdgcn_s_sleep(1); \
    if ((++_sp & 255u) == 0u) { if (xb_ld(&(bar)[XB_TMO])) break; if (_sp > XB_SPIN_CAP) { atomicAdd(&(bar)[XB_TMO], 1u); break; } } } } while (0)

struct XcdBarrier {
    unsigned* bar; unsigned x;
    volatile LAS unsigned* st;
};

__device__ __forceinline__ XcdBarrier xcd_barrier_post(unsigned* bar, volatile LAS unsigned* st) {
    XcdBarrier b; b.bar = bar; b.x = xb_xcc_id(); b.st = st;
    if (threadIdx.x == 0) (void)xb_add(&bar[XB_XCNT(b.x)], 1u);
    return b;
}
__device__ __forceinline__ void xcd_barrier_complete(unsigned* bar, unsigned x, unsigned& nloc, unsigned& nx) {
    const unsigned G = gridDim.x * gridDim.y * gridDim.z;
    unsigned sum, cnt, mine, sp = 0u;
    for (;;) {
        sum = 0u; cnt = 0u; mine = 0u;
#pragma unroll
        for (unsigned j = 0; j < 16; ++j) { const unsigned c = xb_ld(&bar[XB_XCNT(j)]); sum += c; cnt += (c > 0u) ? 1u : 0u; mine = (j == x) ? c : mine; }
        if (sum == G) break;
        __builtin_amdgcn_s_sleep(1);
        if ((++sp & 255u) == 0u) { if (xb_ld(&bar[XB_TMO])) break; if (sp > XB_SPIN_CAP) { atomicAdd(&bar[XB_TMO], 1u); break; } }
    }
    nloc = mine > 0u ? mine : 1u; nx = cnt > 0u ? cnt : 1u;
}

__device__ __forceinline__ void xcd_barrier(const XcdBarrier& b) {
    asm volatile("s_waitcnt vmcnt(0)" ::: "memory");
    __syncthreads();
    if (threadIdx.x == 0) {
        unsigned* bar = b.bar;
        __builtin_amdgcn_s_waitcnt(0);
        unsigned nloc = b.st[0], nx = b.st[1];
        if (nloc == 0u) { xcd_barrier_complete(bar, b.x, nloc, nx); b.st[0] = nloc; b.st[1] = nx; }
        const unsigned old = xb_add(&bar[XB_XSUB(b.x)], 1u);
        const unsigned gen = old / nloc;
        if (old + 1u == (gen + 1u) * nloc) {
            __builtin_amdgcn_fence(__ATOMIC_RELEASE, "agent");
            asm volatile("s_waitcnt vmcnt(0)" ::: "memory");
            const unsigned og = xb_add(&bar[XB_TOP], 1u);
            const unsigned tg = og / nx;
            if (og + 1u == (tg + 1u) * nx) xb_add(&bar[XB_TOPGEN], 1u);
            else XB_SPIN(xb_ld(&bar[XB_TOPGEN]) == tg, bar);
            __builtin_amdgcn_fence(__ATOMIC_ACQUIRE, "agent");
            xb_add(&bar[XB_XGEN(b.x)], 1u);
            asm volatile("s_waitcnt vmcnt(0)" ::: "memory");
        } else {
            XB_SPIN(xb_ld(&bar[XB_XGEN(b.x)]) == gen, bar);
            __builtin_amdgcn_fence(__ATOMIC_ACQUIRE, "agent");
            asm volatile("s_waitcnt vmcnt(0)" ::: "memory");
        }
    }
    __syncthreads();
}

namespace attn_body {
using bf16=_Float16;
using bf16x8=__attribute__((ext_vector_type(8)))_Float16;
using s16x4=__attribute__((ext_vector_type(4)))_Float16;
typedef float f32x4_t __attribute__((ext_vector_type(4)));
using f32x16=__attribute__((ext_vector_type(16)))float;
using u32x4=__attribute__((ext_vector_type(4)))unsigned;
constexpr int BATCH=8,NHEAD=8,SEQ=4096,D=64,DM=NHEAD*D,OPITCH=1024;
constexpr int NW=8,QBLK=32,QB=QBLK*NW,KVBLK=64,NQB=SEQ/QB;
constexpr int ATTN_PITCH=DM, ATTN_UNIT_ROWS=QB;
__device__ __forceinline__ int crow(int r,int hi){return (r&3)+8*(r>>2)+4*hi;}
#define SBAR() __builtin_amdgcn_sched_barrier(0)
__device__ __forceinline__ void cmask(f32x16&p0,f32x16&p1,int jb,int qrel,int hi){
  const float NEG=-INFINITY; int kb=64*jb+4*hi;
  #pragma unroll
  for(int r=0;r<16;++r){int kv=kb+(r&3)+8*(r>>2); if(kv>qrel)p0[r]=NEG; if(kv+32>qrel)p1[r]=NEG;}
}

constexpr int NSLOT=3, SLOTB=8192, LDS_MK=103424;
constexpr int LDS_K=0, LDS_V=NSLOT*SLOTB, LDS_WS=2*NSLOT*SLOTB, LDS_OST=LDS_WS+NW*64*4, LDS_BYTES=LDS_OST+NW*4096;
constexpr float C2=0.125f*1.4426950408889634f;
__device__ __forceinline__ void glds16(const void*gsrc,unsigned lds_dst){unsigned keep;
  asm volatile("s_mov_b32 %0, m0\n\ts_mov_b32 m0, %2\n\ts_nop 0\n\tglobal_load_lds_dwordx4 %1, off\n\ts_mov_b32 m0, %0":"=&s"(keep):"v"(gsrc),"s"(lds_dst):"memory");}
__device__ __forceinline__ void glds4(const void*gsrc,unsigned lds_dst){unsigned keep;
  asm volatile("s_mov_b32 %0, m0\n\ts_mov_b32 m0, %2\n\ts_nop 0\n\tglobal_load_lds_dword %1, off\n\ts_mov_b32 m0, %0":"=&s"(keep):"v"(gsrc),"s"(lds_dst):"memory");}
__device__ __forceinline__ float max3f(float a,float b,float c){float r;asm("v_max3_f32 %0, %1, %2, %3":"=v"(r):"v"(a),"v"(b),"v"(c));return r;}
__device__ __forceinline__ float max2f(float a,float b){float r;asm("v_max_f32_e32 %0, %1, %2":"=v"(r):"v"(a),"v"(b));return r;}
__device__ __forceinline__ float fadd_s(float a,float b){float r;asm("v_add_f32_e32 %0, %1, %2":"=v"(r):"v"(a),"v"(b));return r;}
__device__ __forceinline__ float fsub_s(float a,float b){float r;asm("v_sub_f32_e32 %0, %1, %2":"=v"(r):"v"(a),"v"(b));return r;}
typedef float f32x2_t __attribute__((ext_vector_type(2))); typedef _Float16 bf16x2_t __attribute__((ext_vector_type(2)));
__device__ __forceinline__ unsigned cvtpk_s(float lo,float hi){f32x2_t v={lo,hi};bf16x2_t b=__builtin_convertvector(v,bf16x2_t);return __builtin_bit_cast(unsigned,b);}
#define WAIT_BAR(N) asm volatile("s_waitcnt vmcnt(" #N ") lgkmcnt(0)\n\ts_barrier":::"memory")

__device__ __forceinline__ void qkt(f32x16&p0,f32x16&p1,const char*Kslot,const bf16x8*qr,const f32x16&negm,int r32,int hi){
  const char*kb=Kslot+hi*1024+r32*16;
  #pragma unroll
  for(int d0=0;d0<4;++d0){
    const bf16x8 b0=*reinterpret_cast<const bf16x8*>(kb+d0*2048);
    const bf16x8 b1=*reinterpret_cast<const bf16x8*>(kb+d0*2048+512);
    if(d0==0){p0=__builtin_amdgcn_mfma_f32_32x32x16_f16(b0,qr[0],negm,0,0,0);p1=__builtin_amdgcn_mfma_f32_32x32x16_f16(b1,qr[0],negm,0,0,0);}
    else{p0=__builtin_amdgcn_mfma_f32_32x32x16_f16(b0,qr[d0],p0,0,0,0);p1=__builtin_amdgcn_mfma_f32_32x32x16_f16(b1,qr[d0],p1,0,0,0);}}
}
typedef __attribute__((address_space(3))) const char* lds_cptr;
typedef short v4i16_t __attribute__((ext_vector_type(4)));
__device__ __forceinline__ void kload8(bf16x8*kf,lds_cptr kp){
  kf[0]=*(const __attribute__((address_space(3))) bf16x8*)(kp);      kf[1]=*(const __attribute__((address_space(3))) bf16x8*)(kp+512);
  kf[2]=*(const __attribute__((address_space(3))) bf16x8*)(kp+2048); kf[3]=*(const __attribute__((address_space(3))) bf16x8*)(kp+2560);
  kf[4]=*(const __attribute__((address_space(3))) bf16x8*)(kp+4096); kf[5]=*(const __attribute__((address_space(3))) bf16x8*)(kp+4608);
  kf[6]=*(const __attribute__((address_space(3))) bf16x8*)(kp+6144); kf[7]=*(const __attribute__((address_space(3))) bf16x8*)(kp+6656);
}
__device__ __forceinline__ void kload2(bf16x8*kf,lds_cptr kp,int j){ kf[2*j]=*(const __attribute__((address_space(3))) bf16x8*)(kp+j*2048); kf[2*j+1]=*(const __attribute__((address_space(3))) bf16x8*)(kp+j*2048+512); }
__device__ __forceinline__ s16x4 vtr(lds_cptr p){ return __builtin_bit_cast(s16x4,__builtin_amdgcn_ds_read_tr16_b64_v4i16((__attribute__((address_space(3))) v4i16_t*)p)); }
__device__ __forceinline__ float rowmax(const f32x16&p0,const f32x16&p1){
  float a=max3f(p0[0],p0[1],p1[0]),b=max3f(p0[2],p0[3],p1[1]);a=max3f(a,p1[2],p1[3]);
  #pragma unroll
  for(int r=4;r<16;r+=4){a=max3f(a,p0[r],p0[r+1]);b=max3f(b,p0[r+2],p0[r+3]);a=max3f(a,p1[r],p1[r+1]);b=max3f(b,p1[r+2],p1[r+3]);}
  const float m=max2f(a,b);
  auto rr=__builtin_amdgcn_permlane32_swap(__float_as_uint(m),__float_as_uint(m),false,false);
  return max2f(__uint_as_float(rr[0]),__uint_as_float(rr[1]));
}
__device__ __forceinline__ void pv(f32x16*o,int vb,bf16x8 pa0,bf16x8 pa1,bf16x8 pa2,bf16x8 pa3){
  #pragma unroll
  for(int d0=0;d0<2;++d0){s16x4 lo[4],hi[4];
    #pragma unroll
    for(int ks=0;ks<4;++ks){
      asm volatile("ds_read_b64_tr_b16 %0,%1 offset:%c2":"=&v"(lo[ks]):"v"(vb),"i"(d0*4096+ks*1024):"memory");
      asm volatile("ds_read_b64_tr_b16 %0,%1 offset:%c2":"=&v"(hi[ks]):"v"(vb),"i"(d0*4096+ks*1024+512):"memory");}
    asm volatile("s_waitcnt lgkmcnt(0)":::"memory");SBAR();
    #define PK(k) (bf16x8){lo[k][0],lo[k][1],lo[k][2],lo[k][3],hi[k][0],hi[k][1],hi[k][2],hi[k][3]}
    o[d0]=__builtin_amdgcn_mfma_f32_32x32x16_f16(pa0,PK(0),o[d0],0,0,0);
    o[d0]=__builtin_amdgcn_mfma_f32_32x32x16_f16(pa1,PK(1),o[d0],0,0,0);
    o[d0]=__builtin_amdgcn_mfma_f32_32x32x16_f16(pa2,PK(2),o[d0],0,0,0);
    o[d0]=__builtin_amdgcn_mfma_f32_32x32x16_f16(pa3,PK(3),o[d0],0,0,0);
    #undef PK
  }
}

#ifndef ATTN_STORE16
#define ATTN_STORE16(p,v) (*(u32x4*)(p)=(v))
#endif
typedef const __attribute__((address_space(3))) float* lds_cfptr;
template<int THRL,int MODE> __device__ __forceinline__ void attn_unit(int b,int h,int qb,const bf16*Q,const bf16*__restrict__ K,const bf16*__restrict__ V,bf16*O,float*ssq,int grp,lds_cfptr biasL,const unsigned*maskp,char*shm){
  int tid_=threadIdx.x; asm volatile("":"+v"(tid_));
  const int tid=tid_,lane=tid&63,r32=lane&31,hi=lane>>5; const int wid=__builtin_amdgcn_readfirstlane(tid>>6);
  const long rowbase=(long)b*SEQ; const int q0=qb*QB;
  const bf16*Qw=Q+(rowbase+q0+wid*QBLK)*DM+h*D;
  const bf16*Kh=K+rowbase*DM+h*D,*Vh=V+rowbase*DM+h*D;
  const unsigned lds0=(unsigned)(uintptr_t)shm;
  float*wsf=(float*)(shm+LDS_WS)+wid*64;
  const bf16*ksrc=Kh+(long)lane*DM+wid*8;
  const bf16*vsrc=Vh+(long)(16*(wid&3)+(lane>>2))*DM+(wid>>2)*32+(lane&3)*8;
  const unsigned kdst=lds0+LDS_K+wid*1024, vdst=lds0+LDS_V+wid*1024;
  #define DMA_K(t,slot) glds16(ksrc+(long)(t)*KVBLK*DM,(unsigned)__builtin_amdgcn_readfirstlane(kdst+(slot)))
  #define DMA_V(t,slot) glds16(vsrc+(long)(t)*KVBLK*DM,(unsigned)__builtin_amdgcn_readfirstlane(vdst+(slot)))
  const int vb0=(int)(lds0+LDS_V)+((lane>>4)&1)*32+(lane&3)*8+(4*hi+((lane&15)>>2))*64;
  const char*Kbase=shm+LDS_K; bf16x8 kf[8];
  const lds_cptr shm3=(lds_cptr)shm; const lds_cptr kp0=shm3+LDS_K+hi*1024+r32*16; const lds_cptr vp0=shm3+LDS_V+((lane>>4)&1)*32+(lane&3)*8+(4*hi+((lane&15)>>2))*64;
  const int NT=(q0+QB)/KVBLK;
  const int qrel=wid*QBLK+r32;
  unsigned mkA=0xffffffffu,mkB=0xffffffffu; const unsigned*mk_src=maskp+(rowbase+q0+qrel)*128+hi;
  const unsigned mk_lds=lds0+LDS_MK+wid*512; const __attribute__((address_space(3))) unsigned* mk_rd=(const __attribute__((address_space(3))) unsigned*)(shm3+LDS_MK+wid*512)+lane;
  #define MLOAD(t) do{ if(MODE==1){ glds4(mk_src+2*(t),(unsigned)__builtin_amdgcn_readfirstlane(mk_lds+(((t)&1)*256))); } }while(0)
  #define MREAD(MK,sl) do{ if(MODE==1){ MK=mk_rd[(sl)*64]; } }while(0)
  MLOAD(0); MLOAD(1);
  float bq=0.f; if(MODE==0) bq=biasL[q0+qrel];
  DMA_K(0,0);DMA_V(0,0);DMA_K(1,SLOTB);
  bf16x8 qr[4];
  #pragma unroll
  for(int d0=0;d0<4;++d0)qr[d0]=*reinterpret_cast<const bf16x8*>(&Qw[(long)r32*DM+d0*16+hi*8]);
  float zf_; asm volatile("v_mov_b32 %0, 0":"=v"(zf_));
  float mhat=0.f,l_reg=0.f;f32x16 o[2];f32x16 negm;
  #pragma unroll
  for(int r=0;r<16;++r){o[0][r]=zf_;o[1][r]=zf_;negm[r]=zf_;}
  asm volatile("":"+v"(negm));
  #define CMASK(P0,P1,t) do{int jb_=(t)-(NT-4); if(jb_>=0)cmask(P0,P1,jb_,qrel,hi);}while(0)
  #define BIAS(P0,P1,t) do{ if(MODE==0){ const lds_cfptr bp_=biasL+(t)*64+4*hi; \
      _Pragma("unroll") for(int g_=0;g_<4;++g_){ const f32x4_t b0_=*(const __attribute__((address_space(3))) f32x4_t*)(bp_+8*g_), b1_=*(const __attribute__((address_space(3))) f32x4_t*)(bp_+32+8*g_); \
        _Pragma("unroll") for(int e_=0;e_<4;++e_){ P0[4*g_+e_]+=b0_[e_]; P1[4*g_+e_]+=b1_[e_]; } } } }while(0)
  #define MASKX(X,B,SH,MK) do{ if(MODE==1){ _Pragma("unroll") for(int i_=0;i_<4;++i_) X[(B)+i_]=__uint_as_float(__float_as_uint(X[(B)+i_])&(unsigned)__builtin_amdgcn_sbfe((int)(MK),(SH)+(B)+i_,1)); } }while(0)
  bool resc=false;
  #define START(P0,P1) do{ const float rm=(MODE==0)?bq:rowmax(P0,P1); resc=false; \
    { const float dl=rm; mhat=fadd_s(mhat,dl); \
      _Pragma("unroll") for(int r=0;r<16;++r){P0[r]=fsub_s(P0[r],dl);P1[r]=fsub_s(P1[r],dl);} \
      _Pragma("unroll") for(int r=0;r<16;++r)negm[r]=-mhat; asm volatile("":"+v"(negm)); } \
    _Pragma("unroll") for(int r=0;r<16;++r)P0[r]=__builtin_amdgcn_exp2f(P0[r]); \
    MASKX(P0,0,0,mkA);MASKX(P0,4,0,mkA);MASKX(P0,8,0,mkA);MASKX(P0,12,0,mkA); }while(0)
  #define RESC() do{ if(resc){ asm volatile("s_waitcnt lgkmcnt(0)":::"memory"); \
      _Pragma("unroll") for(int d_=0;d_<2;++d_) _Pragma("unroll") for(int r=0;r<16;++r)o[d_][r]*=wsf[crow(r,hi)]; } }while(0)
  f32x16 pA0,pA1,pB0,pB1;
  int sl_prev=0,sl_cur=0,sl_next=SLOTB;
  #define ROT() do{sl_prev=sl_cur;sl_cur=sl_next;sl_next=(sl_next==(NSLOT-1)*SLOTB)?0:sl_next+SLOTB;}while(0)
  DMA_K(2,2*SLOTB);
  WAIT_BAR(3); MREAD(mkA,0); MREAD(mkB,1);
  qkt(pA0,pA1,Kbase,qr,negm,r32,hi);asm volatile("s_nop 15\n\ts_nop 7":"+v"(pA0),"+v"(pA1));BIAS(pA0,pA1,0);CMASK(pA0,pA1,0);
  START(pA0,pA1);
  _Pragma("unroll") for(int r=0;r<16;++r)pA1[r]=__builtin_amdgcn_exp2f(pA1[r]);
  MASKX(pA1,0,16,mkA);MASKX(pA1,4,16,mkA);MASKX(pA1,8,16,mkA);MASKX(pA1,12,16,mkA);
  WAIT_BAR(0);
  DMA_K(3,0);DMA_V(1,SLOTB);
  ROT();
  kload8(kf,kp0+sl_cur);
  WAIT_BAR(2);
  s16x4 vlo[8],vhi[8]; u32x4 pw0,pw1,pw2,pw3;
  #define PKW(P,B) cvtpk_s(P[B],P[B+1])
  #define PAF(k) __builtin_bit_cast(bf16x8,pw##k)
  #define VFR(i) (bf16x8){vlo[i][0],vlo[i][1],vlo[i][2],vlo[i][3],vhi[i][0],vhi[i][1],vhi[i][2],vhi[i][3]}
  #define PIN(x) asm volatile("":"+v"(x))
  #define MX3(a,b,c) __builtin_fmaxf(__builtin_fmaxf((a),(b)),(c))
  #define GAPA(MF,A0,A1,A2,A3,W0,W1,PW) do{ MF; sacc+=A0; sacc+=A1; sacc+=A2; sacc+=A3; PIN(sacc); W0; W1; PIN(PW); SBAR(); }while(0)
  #define EX(v) __builtin_amdgcn_exp2f(v)
  #define GAPB(MF,X,B,SH) do{ MF; X[B]=EX(X[B]); X[B+1]=EX(X[B+1]); X[B+2]=EX(X[B+2]); X[B+3]=EX(X[B+3]); MASKX(X,B,SH,MKC_); PIN(X); SBAR(); }while(0)
  #define VRD(i) do{ vlo[i]=vtr(vp_+(((i)>>2)*4096+((i)&3)*1024)); vhi[i]=vtr(vp_+(((i)>>2)*4096+((i)&3)*1024+512)); }while(0)
  #define KRD(G,j) do{ if(G){ kload2(kf,kp0+sl_next,j); SBAR(); } }while(0)
  #define STEP(C0,C1,P0,P1,t,GK,GV,GL,MKC) do{ SBAR(); \
    const unsigned MKC_=(MKC); \
    const lds_cptr vp_=vp0+sl_prev; \
    VRD(0); SBAR(); float sacc=(P0[0]+P0[1]); \
    GAPA(C0=__builtin_amdgcn_mfma_f32_32x32x16_f16(kf[0],qr[0],negm,0,0,0), P0[2],P0[3],P0[4],P0[5],     pw0[0]=PKW(P0,0), pw0[1]=PKW(P0,2), pw0); \
    VRD(4); SBAR(); GAPA(C1=__builtin_amdgcn_mfma_f32_32x32x16_f16(kf[1],qr[0],negm,0,0,0), P0[6],P0[7],P0[8],P0[9],     pw0[2]=PKW(P0,4), pw0[3]=PKW(P0,6), pw0); \
    VRD(1); SBAR(); GAPA(C0=__builtin_amdgcn_mfma_f32_32x32x16_f16(kf[2],qr[1],C0,0,0,0),   P0[10],P0[11],P0[12],P0[13], pw1[0]=PKW(P0,8), pw1[1]=PKW(P0,10), pw1); \
    VRD(5); SBAR(); GAPA(C1=__builtin_amdgcn_mfma_f32_32x32x16_f16(kf[3],qr[1],C1,0,0,0),   P0[14],P0[15],P1[0],P1[1],   pw1[2]=PKW(P0,12),pw1[3]=PKW(P0,14), pw1); \
    VRD(2); SBAR(); GAPA(C0=__builtin_amdgcn_mfma_f32_32x32x16_f16(kf[4],qr[2],C0,0,0,0),   P1[2],P1[3],P1[4],P1[5],     pw2[0]=PKW(P1,0), pw2[1]=PKW(P1,2), pw2); \
    VRD(6); SBAR(); GAPA(C1=__builtin_amdgcn_mfma_f32_32x32x16_f16(kf[5],qr[2],C1,0,0,0),   P1[6],P1[7],P1[8],P1[9],     pw2[2]=PKW(P1,4), pw2[3]=PKW(P1,6), pw2); \
    VRD(3); SBAR(); GAPA(C0=__builtin_amdgcn_mfma_f32_32x32x16_f16(kf[6],qr[3],C0,0,0,0),   P1[10],P1[11],P1[12],P1[13], pw3[0]=PKW(P1,8), pw3[1]=PKW(P1,10), pw3); \
    VRD(7); SBAR(); GAPA(C1=__builtin_amdgcn_mfma_f32_32x32x16_f16(kf[7],qr[3],C1,0,0,0),   P1[14],P1[15],0.f,0.f,       pw3[2]=PKW(P1,12),pw3[3]=PKW(P1,14), pw3); \
    l_reg+=sacc; \
    if(GV){MLOAD((t)+1);} if(GK){DMA_K((t)+3,sl_cur);} if(GV){DMA_V((t)+1,sl_next);} \
    BIAS(C0,C1,t); CMASK(C0,C1,t); \
    { float a=MX3(C0[0],C0[1],C1[0]),b=MX3(C0[2],C0[3],C1[1]); a=MX3(a,C1[2],C1[3]); \
      _Pragma("unroll") for(int r=4;r<16;r+=4){a=MX3(a,C0[r],C0[r+1]);b=MX3(b,C0[r+2],C0[r+3]);a=MX3(a,C1[r],C1[r+1]);b=MX3(b,C1[r+2],C1[r+3]);} \
      float rm=__builtin_fmaxf(a,b); { auto rr=__builtin_amdgcn_permlane32_swap(__float_as_uint(rm),__float_as_uint(rm),false,false); rm=__builtin_fmaxf(__uint_as_float(rr[0]),__uint_as_float(rr[1])); } \
      resc=false; \
      if(__builtin_expect(__any(rm>(float)THRL),0)){ const float dl=__builtin_fmaxf(rm,0.f); mhat+=dl; \
        _Pragma("unroll") for(int r=0;r<16;++r){C0[r]-=dl;C1[r]-=dl;} \
        _Pragma("unroll") for(int r=0;r<16;++r)negm[r]=-mhat; asm volatile("":"+v"(negm)); \
        const float f=__builtin_amdgcn_exp2f(-dl); l_reg*=f; if(hi==0)wsf[r32]=f; resc=true; } } \
    SBAR(); \
    GAPB(o[0]=__builtin_amdgcn_mfma_f32_32x32x16_f16(PAF(0),VFR(0),o[0],0,0,0), C0,0,0); \
    GAPB(o[1]=__builtin_amdgcn_mfma_f32_32x32x16_f16(PAF(0),VFR(4),o[1],0,0,0), C0,4,0); \
    KRD(GL,0); GAPB(o[0]=__builtin_amdgcn_mfma_f32_32x32x16_f16(PAF(1),VFR(1),o[0],0,0,0), C0,8,0); \
    KRD(GL,1); GAPB(o[1]=__builtin_amdgcn_mfma_f32_32x32x16_f16(PAF(1),VFR(5),o[1],0,0,0), C0,12,0); \
    KRD(GL,2); GAPB(o[0]=__builtin_amdgcn_mfma_f32_32x32x16_f16(PAF(2),VFR(2),o[0],0,0,0), C1,0,16); \
    KRD(GL,3); GAPB(o[1]=__builtin_amdgcn_mfma_f32_32x32x16_f16(PAF(2),VFR(6),o[1],0,0,0), C1,4,16); \
    GAPB(o[0]=__builtin_amdgcn_mfma_f32_32x32x16_f16(PAF(3),VFR(3),o[0],0,0,0), C1,8,16); \
    GAPB(o[1]=__builtin_amdgcn_mfma_f32_32x32x16_f16(PAF(3),VFR(7),o[1],0,0,0), C1,12,16); \
    }while(0)
  int t=1;
  #undef CMASK
  #define CMASK(P0,P1,t) do{}while(0)
  for(;t+5<NT;t+=2){
    STEP(pB0,pB1,pA0,pA1,t,true,true,true,mkB);     WAIT_BAR(2); MREAD(mkA,0); RESC(); ROT();
    STEP(pA0,pA1,pB0,pB1,t+1,true,true,true,mkA);   WAIT_BAR(2); MREAD(mkB,1); RESC(); ROT();
  }
  #undef CMASK
  #define CMASK(P0,P1,t) do{int jb_=(t)-(NT-4); if(jb_>=0)cmask(P0,P1,jb_,qrel,hi);}while(0)
  #define ENDW(tt) do{ if((tt)+3<NT){WAIT_BAR(2);} else if((tt)+2<NT){WAIT_BAR(1);} else {WAIT_BAR(0);} }while(0)
  for(;t+1<NT;t+=2){
    STEP(pB0,pB1,pA0,pA1,t,(t+3<NT),(t+1<NT),(t+1<NT),mkB);       ENDW(t);   MREAD(mkA,0); RESC(); ROT();
    STEP(pA0,pA1,pB0,pB1,t+1,(t+4<NT),(t+2<NT),(t+2<NT),mkA);     ENDW(t+1); MREAD(mkB,1); RESC(); ROT();
  }
  STEP(pB0,pB1,pA0,pA1,NT-1,false,false,false,mkB); RESC();
  { float sacc=pB0[0]+pB0[1]; _Pragma("unroll") for(int r=2;r<16;++r)sacc+=pB0[r]; _Pragma("unroll") for(int r=0;r<16;++r)sacc+=pB1[r]; l_reg+=sacc;
    pw0=(u32x4){PKW(pB0,0),PKW(pB0,2),PKW(pB0,4),PKW(pB0,6)};pw1=(u32x4){PKW(pB0,8),PKW(pB0,10),PKW(pB0,12),PKW(pB0,14)};pw2=(u32x4){PKW(pB1,0),PKW(pB1,2),PKW(pB1,4),PKW(pB1,6)};pw3=(u32x4){PKW(pB1,8),PKW(pB1,10),PKW(pB1,12),PKW(pB1,14)};
    SBAR(); pv(o,vb0+sl_cur,PAF(0),PAF(1),PAF(2),PAF(3)); }
  #undef PKW
  #undef PAF
  #undef VFR
  #undef PIN
  #undef MX3
  #undef GAPA
  #undef GAPB
  #undef EX
  #undef VRD
  #undef KRD
  #undef STEP
  #undef ENDW
  {auto rr=__builtin_amdgcn_permlane32_swap(__float_as_uint(l_reg),__float_as_uint(l_reg),false,false);l_reg=__uint_as_float(rr[0])+__uint_as_float(rr[1]);}
  if(hi==0)wsf[32+r32]=l_reg;asm volatile("s_waitcnt lgkmcnt(0)":::"memory");
  float rli[16];
  #pragma unroll
  for(int r=0;r<16;++r)rli[r]=__builtin_amdgcn_rcpf(wsf[32+crow(r,hi)]);
  bf16*Ow=O+(rowbase+q0+wid*QBLK)*OPITCH+grp*512+h*D; float*sq=ssq+(size_t)(grp*8+h)*((size_t)BATCH*SEQ)+(rowbase+q0+wid*QBLK);
  { bf16*stg=(bf16*)(shm+LDS_OST)+wid*2048;
    #pragma unroll
    for(int r=0;r<16;++r){const int orow=crow(r,hi);
      #pragma unroll
      for(int d0=0;d0<2;++d0)stg[orow*64+d0*32+r32]=(bf16)(o[d0][r]*rli[r]);}
    asm volatile("s_waitcnt lgkmcnt(0)":::"memory");
    #pragma unroll
    for(int i=0;i<4;++i){const int row=i*8+(lane>>3),ch=lane&7; const u32x4 v=*(const u32x4*)(stg+row*64+ch*8); ATTN_STORE16(Ow+(long)row*OPITCH+ch*8,v);
      float s2=0.f;
      #pragma unroll
      for(int e=0;e<4;++e){const unsigned we=v[e]; const bf16x2_t hv=__builtin_bit_cast(bf16x2_t,we); const float a0=(float)hv[0],a1=(float)hv[1]; s2+=a0*a0+a1*a1;}
      s2+=__shfl_xor(s2,1); s2+=__shfl_xor(s2,2); s2+=__shfl_xor(s2,4);
      if(ch==0)sq[row]=s2; } }
  asm volatile("s_waitcnt lgkmcnt(0)\n\ts_barrier":::"memory");
  #undef DMA_K
  #undef DMA_V
  #undef CMASK
  #undef START
  #undef RESC
  #undef ROT
}
constexpr int ATTN_LDS_BYTES=LDS_BYTES;
#undef SBAR
#undef WAIT_BAR
}
namespace sel {
constexpr int NTHR = 512;
typedef _Float16 h8 __attribute__((ext_vector_type(8)));
typedef float f32x16 __attribute__((ext_vector_type(16)));
constexpr int NB = 512, HSTR = 513, CAP = 64;
constexpr int L_HIST = 0, L_MASK = 65792, L_CAND = L_MASK + 16384, L_T0 = L_CAND + 16384, L_KK = L_T0 + 128, L_CNT = L_KK + 128, L_FLAG = L_CNT + 128, L_CJ = L_FLAG + 128, L_END = L_CJ + 2048;
constexpr int F_KEY = 0, F_SEL = 16384, F_HIST = 20480, F_CNT = 21504, F_IQ = 23552, F_MISC = 24576;
__device__ __forceinline__ int crow(int r, int hi) { return (r & 3) + 8 * (r >> 2) + 4 * hi; }
__device__ __forceinline__ int bucket_of(float sc) { const float f = __builtin_fmaf(sc, 64.0f, 256.0f); return (int)__builtin_amdgcn_fmed3f(f, 0.0f, 511.0f); }
__device__ __forceinline__ unsigned mono_key32(float f) { const unsigned u = __float_as_uint(f); return (u & 0x80000000u) ? ~u : (u | 0x80000000u); }

__device__ __forceinline__ void select_row_exact(const f16* iqb, const f16* ikb, const float* iwb, int b, int t, LAS unsigned char* fs, LAS unsigned short* mrow, int tid) {
    LAS unsigned* key = (LAS unsigned*)(fs + F_KEY); LAS unsigned char* selb = (LAS unsigned char*)(fs + F_SEL); LAS unsigned* hist = (LAS unsigned*)(fs + F_HIST);
    LAS unsigned* cnt = (LAS unsigned*)(fs + F_CNT); LAS float* iqf = (LAS float*)(fs + F_IQ); LAS int* misc = (LAS int*)(fs + F_MISC);
    const int n = t + 1; const size_t row = (size_t)b * S_ + t;
    __syncthreads();
    if (tid < 256) iqf[tid] = (float)iqb[row * 256 + tid];
    if (tid < 4) ((LAS float*)misc)[8 + tid] = iwb[row * 4 + tid];
    __syncthreads();
    const float w0 = ((LAS float*)misc)[8], w1 = ((LAS float*)misc)[9], w2 = ((LAS float*)misc)[10], w3 = ((LAS float*)misc)[11];
#pragma unroll 1
    for (int s = tid; s < 4096; s += NTHR) {
        unsigned k = 0u;
        if (s < n) {
            asm volatile("" ::: "memory");
            const f16* kr = ikb + ((size_t)b * S_ + s) * 64;
            float d0 = 0.f, d1 = 0.f, d2 = 0.f, d3 = 0.f;
#pragma unroll 8
            for (int j = 0; j < 64; ++j) { const float kv = (float)kr[j]; d0 += iqf[j] * kv; d1 += iqf[64 + j] * kv; d2 += iqf[128 + j] * kv; d3 += iqf[192 + j] * kv; }
            float sc = fmaxf(d0 * 0.125f, 0.f) * w0; sc += fmaxf(d1 * 0.125f, 0.f) * w1; sc += fmaxf(d2 * 0.125f, 0.f) * w2; sc += fmaxf(d3 * 0.125f, 0.f) * w3;
            k = mono_key32(sc);
        }
        key[s] = k;
    }
    __syncthreads();
    unsigned prefix = 0u, pmask = 0u; int kk = 256;
    for (int shift = 24; shift >= 0; shift -= 8) {
        if (tid < 256) hist[tid] = 0u;
        __syncthreads();
        for (int s = tid; s < n; s += NTHR) { const unsigned k = key[s]; if ((k & pmask) == prefix) __hip_atomic_fetch_add(&hist[(k >> shift) & 255u], 1u, __ATOMIC_RELAXED, __HIP_MEMORY_SCOPE_WORKGROUP); }
        __syncthreads();
        if (tid == 0) { int c = 0, bin = 255; while (bin > 0 && c + (int)hist[bin] < kk) { c += (int)hist[bin]; --bin; } misc[0] = bin; misc[1] = kk - c; }
        __syncthreads();
        prefix |= (unsigned)misc[0] << shift; pmask |= 255u << shift; kk = misc[1];
        __syncthreads();
    }
    unsigned ceq = 0u;
    for (int i = 0; i < 8; ++i) { const int s = tid * 8 + i; if (s < n && key[s] == prefix) ++ceq; }
    cnt[tid] = ceq; __syncthreads();
    unsigned before = 0u; for (int j = 0; j < tid; ++j) before += cnt[j];
    for (int i = 0; i < 8; ++i) { const int s = tid * 8 + i; unsigned char v = 0; if (s < n) { const unsigned k = key[s];
        if (k > prefix) v = 1; else if (k == prefix) { if ((int)before < kk) v = 1; ++before; } } selb[s] = v; }
    __syncthreads();
    if (tid < 256) { const int hw = tid, J = hw >> 2, hi = (hw >> 1) & 1, j = 2 * J + (hw & 1); unsigned bits = 0u;
        for (int r = 0; r < 16; ++r) { if (selb[32 * j + crow(r, hi)]) bits |= 1u << r; }
        mrow[hw] = (unsigned short)bits; }
    __syncthreads();
}

template <int PASS> __device__ __forceinline__ void score_pass(const f16* ikb, int b, int qt, int wave, int lane, const h8 (&bq)[4][4], float w0, float w1, float w2, float w3,
                                                               LAS unsigned* hist, LAS unsigned short* maskL, LAS unsigned* cand, LAS unsigned* ccnt, int T0) {
    const int ql = lane & 31, hi = lane >> 5;
    const f16* kbase = ikb + ((size_t)b * S_ + ql) * 64 + 8 * hi;
    h8 a[4], an[4];
    if (wave <= qt) {
#pragma unroll
        for (int ks = 0; ks < 4; ++ks) a[ks] = *(const h8*)(kbase + (size_t)(32 * wave) * 64 + 16 * ks); }
    for (int kt = wave; kt <= qt; kt += 8) {
        const bool more = (kt + 8 <= qt);
        if (more) {
#pragma unroll
            for (int ks = 0; ks < 4; ++ks) an[ks] = *(const h8*)(kbase + (size_t)(32 * (kt + 8)) * 64 + 16 * ks); }
        f32x16 acc[4];
#pragma unroll
        for (int h = 0; h < 4; ++h) { acc[h] = __builtin_amdgcn_mfma_f32_32x32x16_f16(a[0], bq[h][0], (f32x16){0.f}, 0, 0, 0);
#pragma unroll
            for (int ks = 1; ks < 4; ++ks) acc[h] = __builtin_amdgcn_mfma_f32_32x32x16_f16(a[ks], bq[h][ks], acc[h], 0, 0, 0); }
        const bool diag = (kt == qt);
        unsigned bits = 0u;
#pragma unroll
        for (int r = 0; r < 16; ++r) {
            float sc = fmaxf(acc[0][r], 0.f) * w0; sc = __builtin_fmaf(fmaxf(acc[1][r], 0.f), w1, sc); sc = __builtin_fmaf(fmaxf(acc[2][r], 0.f), w2, sc); sc = __builtin_fmaf(fmaxf(acc[3][r], 0.f), w3, sc);
            const int bk = bucket_of(sc);
            const bool valid = !diag || (crow(r, hi) <= ql);
            if (PASS == 1) { if (valid) __hip_atomic_fetch_add(hist + ql * HSTR + bk, 1u, __ATOMIC_RELAXED, __HIP_MEMORY_SCOPE_WORKGROUP); }
            else {
                if (valid && bk > T0) bits |= 1u << r;
                if (valid && bk == T0) { const unsigned slot = __hip_atomic_fetch_add(ccnt + ql, 1u, __ATOMIC_RELAXED, __HIP_MEMORY_SCOPE_WORKGROUP);
                    if (slot < (unsigned)CAP) { cand[(ql * CAP + slot) * 2] = mono_key32(sc); cand[(ql * CAP + slot) * 2 + 1] = (unsigned)(32 * kt + crow(r, hi)); } }
            }
        }
        if (PASS == 2) maskL[ql * 256 + (((kt >> 1) * 2 + hi) * 2 + (kt & 1))] = (unsigned short)bits;
        if (more) {
#pragma unroll
            for (int ks = 0; ks < 4; ++ks) a[ks] = an[ks]; }
    }
}

__device__ __forceinline__ void select_unit(const f16* iqb, const f16* ikb, const float* iwb, unsigned short* mask, int b, int qt, LAS unsigned char* lds, int wave) {
    int tid = threadIdx.x; asm volatile("" : "+v"(tid)); const int lane = tid & 63;
    const int t0 = 32 * qt;
    LAS unsigned* hist = (LAS unsigned*)(lds + L_HIST); LAS unsigned short* maskL = (LAS unsigned short*)(lds + L_MASK); LAS unsigned* cand = (LAS unsigned*)(lds + L_CAND);
    LAS int* T0s = (LAS int*)(lds + L_T0); LAS int* KKs = (LAS int*)(lds + L_KK); LAS unsigned* ccnt = (LAS unsigned*)(lds + L_CNT); LAS unsigned* flag = (LAS unsigned*)(lds + L_FLAG); LAS unsigned* cj = (LAS unsigned*)(lds + L_CJ);
    __syncthreads();
    if (qt < 8) {
        for (int e = tid; e < 32 * 256; e += NTHR) { const int q = e >> 8, hw = e & 255, J = hw >> 2, hi = (hw >> 1) & 1, j = 2 * J + (hw & 1), t = t0 + q; unsigned bits = 0u;
#pragma unroll
            for (int r = 0; r < 16; ++r) if (32 * j + crow(r, hi) <= t) bits |= 1u << r;
            maskL[e] = (unsigned short)bits; }
    } else {
        for (int e = tid; e < 32 * HSTR; e += NTHR) hist[e] = 0u;
        for (int e = tid; e < 32 * 128; e += NTHR) ((LAS unsigned*)maskL)[e] = 0u;
        if (tid < 32) { ccnt[tid] = 0u; flag[tid] = 0u; }
        const int ql = lane & 31, hi = lane >> 5; const size_t qrow = (size_t)b * S_ + t0 + ql;
        h8 bq[4][4];
#pragma unroll
        for (int h = 0; h < 4; ++h)
#pragma unroll
            for (int ks = 0; ks < 4; ++ks) bq[h][ks] = *(const h8*)(iqb + qrow * 256 + h * 64 + 16 * ks + 8 * hi);
        const f32x4 wv = *(const f32x4*)(iwb + qrow * 4); const float w0 = wv.x * 0.125f, w1 = wv.y * 0.125f, w2 = wv.z * 0.125f, w3 = wv.w * 0.125f;
        __syncthreads();
        score_pass<1>(ikb, b, qt, wave, lane, bq, w0, w1, w2, w3, hist, maskL, cand, ccnt, 0);
        __syncthreads();
        { const int q = tid >> 4, j = tid & 15; unsigned c = 0u;
          for (int i = 0; i < 32; ++i) c += hist[q * HSTR + 32 * j + i];
          cj[q * 16 + j] = c; }
        __syncthreads();
        { const int q = tid >> 4, j = tid & 15; unsigned above = 0u; for (int j2 = j + 1; j2 < 16; ++j2) above += cj[q * 16 + j2];
          const unsigned mine = cj[q * 16 + j];
          if (above < 256u && above + mine >= 256u) { int bk = 32 * j + 31; unsigned run = above;
              for (;; --bk) { const unsigned hc = hist[q * HSTR + bk]; if (run + hc >= 256u) break; run += hc; }
              T0s[q] = bk; KKs[q] = (int)(256u - run); } }
        __syncthreads();
        const int T0 = T0s[ql];
        score_pass<2>(ikb, b, qt, wave, lane, bq, w0, w1, w2, w3, hist, maskL, cand, ccnt, T0);
        __syncthreads();
        for (int qi = 0; qi < 4; ++qi) { const int q = wave * 4 + qi; const unsigned nc = ccnt[q]; const int kk = KKs[q];
            if (nc > (unsigned)CAP) { if (lane == 0) flag[q] = 1u; continue; }
            unsigned myk = 0u, myi = 0u; const bool have = (unsigned)lane < nc;
            if (have) { myk = cand[(q * CAP + lane) * 2]; myi = cand[(q * CAP + lane) * 2 + 1]; }
            unsigned rank = 0u;
            for (unsigned j = 0; j < nc; ++j) { const unsigned kj = cand[(q * CAP + j) * 2], ij = cand[(q * CAP + j) * 2 + 1]; rank += (kj > myk || (kj == myk && ij < myi)) ? 1u : 0u; }
            if (have && (int)rank < kk) { int hw, bit; { const int s = (int)myi, jt = s >> 5, w = s & 31, h2 = (w >> 2) & 1; bit = (w & 3) | ((w >> 3) << 2); hw = (((jt >> 1) * 2 + h2) * 2 + (jt & 1)); }
                __hip_atomic_fetch_or((LAS unsigned*)maskL + q * 128 + (hw >> 1), 1u << (bit + 16 * (hw & 1)), __ATOMIC_RELAXED, __HIP_MEMORY_SCOPE_WORKGROUP); } }
        __syncthreads();
        for (int q = 0; q < 32; ++q) { if (flag[q] != 0u) select_row_exact(iqb, ikb, iwb, b, t0 + q, lds, maskL + q * 256, tid); }
    }
    __syncthreads();
    { const int q = tid >> 4, j = tid & 15; const LAS v4u* src = (const LAS v4u*)(maskL + q * 256) + 2 * j; GAS v4u* dst = (GAS v4u*)(mask + ((size_t)b * S_ + t0 + q) * 256) + 2 * j;
      dst[0] = src[0]; dst[1] = src[1]; }
}
}
constexpr int NWAVES = 8, NTHR = 512;
constexpr int NPROJ = 3584;
constexpr float C2 = 0.125f * 1.4426950408889634f;
constexpr int RING_BYTES = 131072, LDSCTL_OFF = RING_BYTES, MISC_OFF = LDSCTL_OFF + 320, LDS_BYTES = 147456;
constexpr int CW_TMO = 0, CW_CODE = 1, CW_BAR = 4096;
constexpr int N_PHASES = 11;
constexpr size_t MiB = 1u << 20;

struct FArgs { const float* in[16]; float* out; unsigned* ctl; float* mod; float* rope;
    f16 *win_t, *wout_t, *wgu_t, *wd_t; float *iw, *logf; unsigned* mask; float* ssq;
    f16 *iq, *ik, *h, *o, *qd, *kd, *vd, *qf, *kf, *vf, *act; int ph_lo, ph_hi, li, pad; };

__device__ __forceinline__ float wave_sum(float v) {
#pragma unroll
    for (int o = 1; o < 64; o <<= 1) v += __shfl_xor(v, o);
    return v;
}
__device__ __forceinline__ float fast_silu(float x) { return x * __builtin_amdgcn_rcpf(1.0f + __builtin_amdgcn_exp2f(-1.4426950408889634f * x)); }

__device__ __forceinline__ void tr_item(const float* W, int ldw, int K, int src_col0, f16* WT, int dst_row0, const float* kscale, LAS float* scr, int kb, int lane) {
    const int k0 = 64 * kb;
#pragma unroll 8
    for (int i = 0; i < 32; ++i) { const int kk = 2 * i + (lane >> 5); float v = W[(size_t)(k0 + kk) * ldw + src_col0 + (lane & 31)]; if (kscale) v *= kscale[k0 + kk]; scr[kk * 33 + (lane & 31)] = v; }
    LDS_WAIT(); asm volatile("" ::: "memory");
    const int c = lane & 7;
#pragma unroll
    for (int j = 0; j < 4; ++j) { const int n = (lane >> 3) + 8 * j; const LAS float* s = scr + (8 * c) * 33 + n;
        v4u o; o.x = pkh(s[0 * 33], s[1 * 33]); o.y = pkh(s[2 * 33], s[3 * 33]); o.z = pkh(s[4 * 33], s[5 * 33]); o.w = pkh(s[6 * 33], s[7 * 33]);
        *(GAS v4u*)(WT + (size_t)(dst_row0 + n) * K + k0 + 8 * c) = o; }
    LDS_WAIT(); asm volatile("" ::: "memory");
}

template <bool MODULATE, bool OUT_F16> __device__ __forceinline__ void norm_rows(const float* src, const float* g, const float* mod, int sh_off, int sc_off, f16* dst16, float* dst32, int gw, int ngw, int lane) {
    for (int grp = gw; grp < M_ / 16; grp += ngw) {
        const int row0 = grp * 16, b = row0 / S_;
        f32x4 a[4], sh[4];
#pragma unroll
        for (int j = 0; j < 4; ++j) { a[j] = ((const f32x4*)g)[lane + 64 * j];
            if (MODULATE) { const f32x4 sc = ((const f32x4*)(mod + b * NMOD + sc_off))[lane + 64 * j]; a[j] = a[j] * (sc + 1.0f); sh[j] = ((const f32x4*)(mod + b * NMOD + sh_off))[lane + 64 * j]; }
            else sh[j] = (f32x4){0.f, 0.f, 0.f, 0.f}; }
        for (int r = 0; r < 16; ++r) {
            const size_t roff = (size_t)(row0 + r) * D_;
            f32x4 v[4]; float ss = 0.f;
#pragma unroll
            for (int j = 0; j < 4; ++j) { v[j] = ((const GAS f32x4*)(src + roff))[lane + 64 * j]; ss += (v[j].x * v[j].x + v[j].y * v[j].y) + (v[j].z * v[j].z + v[j].w * v[j].w); }
            const float rstd = 1.0f / sqrtf(wave_sum(ss) * (1.0f / D_) + RMS_EPS);
#pragma unroll
            for (int j = 0; j < 4; ++j) { const f32x4 o = v[j] * rstd * a[j] + sh[j];
                if (OUT_F16) { v2u w; w.x = pkh(o.x, o.y); w.y = pkh(o.z, o.w); ((GAS v2u*)(dst16 + roff))[lane + 64 * j] = w; }
                else ((GAS f32x4*)(dst32 + roff))[lane + 64 * j] = o; }
        }
    }
}

struct EpiProj {
    static constexpr bool PERM = true, AFTER_DRAIN = false;
    f16 *qd, *kd, *vd, *qf, *kf, *vf, *iq, *ik; float *iw, *logf; const float* rope; const float* bfg;
    __device__ __forceinline__ void operator()(const f32x4 (&acc)[2][2][4][2], const pg8::Unit& u, int wr, int wc, int fr, int fq) const {
        const int pn = u.pn, row0 = u.pm * 256 + wr * 64 + fr;
        if (pn < 13) {
            f16* dst; int pitch = 512, colbase = (pn & 1) * 256; float scale = 1.f; bool rope_tile = false;
            if (pn < 12) { const int which = pn >> 1; dst = which == 0 ? qd : which == 1 ? kd : which == 2 ? vd : which == 3 ? qf : which == 4 ? kf : vf;
                if (which == 0 || which == 3) scale = C2; rope_tile = which < 2; }
            else { dst = iq; pitch = 256; colbase = 0; rope_tile = true; }
            const bool do_rope = rope_tile && ((wc & 1) == 0);
            const float sgn = (fq == 0) ? -1.f : 1.f;
#pragma unroll
            for (int ai = 0; ai < 2; ++ai)
#pragma unroll
                for (int m = 0; m < 4; ++m) { const int row = row0 + ai * 128 + m * 16;
                    f32x4 cs[4];
                    if (do_rope) {
#pragma unroll
                        for (int q = 0; q < 4; ++q) cs[q] = ((const f32x4*)(rope + (size_t)row * 16))[q]; }
#pragma unroll
                    for (int bj = 0; bj < 2; ++bj) { f32x4 v0 = acc[ai][bj][m][0], v1 = acc[ai][bj][m][1];
                        if (do_rope) {
                            f32x4 o0, o1;
#pragma unroll
                            for (int e = 0; e < 4; ++e) { o0[e] = __shfl_xor(v0[e], 16); o1[e] = __shfl_xor(v1[e], 16); }
                            if (fq < 2) {
                                v0[0] = v0[0] * cs[0][0] + sgn * o0[0] * cs[0][1]; v0[1] = v0[1] * cs[0][2] + sgn * o0[1] * cs[0][3];
                                v0[2] = v0[2] * cs[1][0] + sgn * o0[2] * cs[1][1]; v0[3] = v0[3] * cs[1][2] + sgn * o0[3] * cs[1][3];
                                v1[0] = v1[0] * cs[2][0] + sgn * o1[0] * cs[2][1]; v1[1] = v1[1] * cs[2][2] + sgn * o1[1] * cs[2][3];
                                v1[2] = v1[2] * cs[3][0] + sgn * o1[2] * cs[3][1]; v1[3] = v1[3] * cs[3][2] + sgn * o1[3] * cs[3][3]; }
                        }
                        v0 = v0 * scale; v1 = v1 * scale;
                        v4u w; w.x = pkh(v0[0], v0[1]); w.y = pkh(v0[2], v0[3]); w.z = pkh(v1[0], v1[1]); w.w = pkh(v1[2], v1[3]);
                        *(GAS v4u*)(dst + (size_t)row * pitch + colbase + bj * 128 + wc * 32 + 8 * fq) = w; } }
        } else {
            const bool do_rope = (wc == 0);
            const float sgn = (fq == 0) ? -1.f : 1.f;
#pragma unroll
            for (int ai = 0; ai < 2; ++ai)
#pragma unroll
                for (int m = 0; m < 4; ++m) { const int row = row0 + ai * 128 + m * 16;
                    f32x4 v0 = acc[ai][0][m][0], v1 = acc[ai][0][m][1];
                    if (wc < 2) {
                        if (do_rope) {
                            f32x4 cs[4];
#pragma unroll
                            for (int q = 0; q < 4; ++q) cs[q] = ((const f32x4*)(rope + (size_t)row * 16))[q];
                            f32x4 o0, o1;
#pragma unroll
                            for (int e = 0; e < 4; ++e) { o0[e] = __shfl_xor(v0[e], 16); o1[e] = __shfl_xor(v1[e], 16); }
                            if (fq < 2) {
                                v0[0] = v0[0] * cs[0][0] + sgn * o0[0] * cs[0][1]; v0[1] = v0[1] * cs[0][2] + sgn * o0[1] * cs[0][3];
                                v0[2] = v0[2] * cs[1][0] + sgn * o0[2] * cs[1][1]; v0[3] = v0[3] * cs[1][2] + sgn * o0[3] * cs[1][3];
                                v1[0] = v1[0] * cs[2][0] + sgn * o1[0] * cs[2][1]; v1[1] = v1[1] * cs[2][2] + sgn * o1[1] * cs[2][3];
                                v1[2] = v1[2] * cs[3][0] + sgn * o1[2] * cs[3][1]; v1[3] = v1[3] * cs[3][2] + sgn * o1[3] * cs[3][3]; }
                        }
                        v4u w; w.x = pkh(v0[0], v0[1]); w.y = pkh(v0[2], v0[3]); w.z = pkh(v1[0], v1[1]); w.w = pkh(v1[2], v1[3]);
                        *(GAS v4u*)(ik + (size_t)row * 64 + wc * 32 + 8 * fq) = w;
                    } else if (wc == 2) {
                        if (fq == 0) { *(GAS f32x4*)(iw + (size_t)row * 4) = v0 * 0.5f; }
                        else if (fq == 1) {
                            const f32x4 b0 = ((const f32x4*)bfg)[0], b1 = ((const f32x4*)bfg)[1]; f32x4 z0 = v0 + b0, z1 = v1 + b1, l0, l1;
#pragma unroll
                            for (int e = 0; e < 4; ++e) { l0[e] = fminf(z0[e], 0.f) - log1pf(expf(-fabsf(z0[e]))); l1[e] = fminf(z1[e], 0.f) - log1pf(expf(-fabsf(z1[e]))); }
                            *(GAS f32x4*)(logf + (size_t)row * 8) = l0; *(GAS f32x4*)(logf + (size_t)row * 8 + 4) = l1; }
                    }
                }
        }
    }
};
struct EpiGateUp {
    static constexpr bool PERM = true, AFTER_DRAIN = false; f16* act;
    __device__ __forceinline__ void operator()(const f32x4 (&acc)[2][2][4][2], const pg8::Unit& u, int wr, int wc, int fr, int fq) const {
        const int row0 = u.pm * 256 + wr * 64 + fr, col0 = u.pn * 128 + wc * 32 + 8 * fq;
#pragma unroll
        for (int ai = 0; ai < 2; ++ai)
#pragma unroll
            for (int m = 0; m < 4; ++m) { const f32x4 g0 = acc[ai][0][m][0], g1 = acc[ai][0][m][1], u0 = acc[ai][1][m][0], u1 = acc[ai][1][m][1];
                v4u w; w.x = pkh(fast_silu(g0[0]) * u0[0], fast_silu(g0[1]) * u0[1]); w.y = pkh(fast_silu(g0[2]) * u0[2], fast_silu(g0[3]) * u0[3]);
                w.z = pkh(fast_silu(g1[0]) * u1[0], fast_silu(g1[1]) * u1[1]); w.w = pkh(fast_silu(g1[2]) * u1[2], fast_silu(g1[3]) * u1[3]);
                *(GAS v4u*)(act + (size_t)(row0 + ai * 128 + m * 16) * DFF + col0) = w; }
    }
};
struct EpiRes {
    static constexpr bool PERM = true, AFTER_DRAIN = false; const float* base; float* out; const float* gvec;
    __device__ __forceinline__ void operator()(const f32x4 (&acc)[2][2][4][2], const pg8::Unit& u, int wr, int wc, int fr, int fq) const {
        const int row0 = u.pm * 256 + wr * 64 + fr, b = (u.pm * 256) / S_;
#pragma unroll
        for (int bj = 0; bj < 2; ++bj) { const int col = u.pn * 256 + bj * 128 + wc * 32 + 8 * fq;
            const f32x4 gv0 = *(const f32x4*)(gvec + b * NMOD + col), gv1 = *(const f32x4*)(gvec + b * NMOD + col + 4);
#pragma unroll
            for (int ai = 0; ai < 2; ++ai)
#pragma unroll
                for (int m = 0; m < 4; ++m) { const size_t off = (size_t)(row0 + ai * 128 + m * 16) * D_ + col;
                    const f32x4 x0 = *(const GAS f32x4*)(base + off), x1 = *(const GAS f32x4*)(base + off + 4);
                    *(GAS f32x4*)(out + off) = x0 + gv0 * acc[ai][bj][m][0]; *(GAS f32x4*)(out + off + 4) = x1 + gv1 * acc[ai][bj][m][1]; } }
    }
};

__global__ void __launch_bounds__(NTHR, 2) fwd(FArgs A) {
    extern __shared__ __attribute__((aligned(16))) unsigned char lds_raw[];
    LAS unsigned char* lds = (LAS unsigned char*)lds_raw;
    volatile LAS unsigned* MISC = (volatile LAS unsigned*)(lds + MISC_OFF);
    const int tid0 = threadIdx.x, wave = __builtin_amdgcn_readfirstlane(tid0 >> 6);
#define PHASE_IDS int tid = threadIdx.x; asm volatile("" : "+v"(tid)); const int lane = tid & 63; (void)lane;
    const int G = gridDim.x; const int bx = blockIdx.x; const int vcu = (G % 8 == 0) ? (bx % 8) * (G / 8) + bx / 8 : bx;
    const int gw = vcu * NWAVES + wave, NGW = G * NWAVES;
    for (int u = tid0; u < (LDS_BYTES - LDSCTL_OFF) / 4; u += NTHR) ((LAS unsigned*)(lds + LDSCTL_OFF))[u] = 0u;
    __syncthreads();
    XcdBarrier bar = xcd_barrier_post(A.ctl + CW_BAR + A.li * XCD_BAR_WORDS, MISC + 8);
    const int lo = A.ph_lo, hi = A.ph_hi;
#define IN(k) (lo <= (k) && (k) < hi)
#define BOTH(k) (IN(k) && IN((k) + 1))
#define GRID_BAR() xcd_barrier(bar)
    const float* x = A.in[0]; const float* cvec = A.in[1]; const int* positions = (const int*)A.in[2]; const float* ada_w = A.in[3]; const float* ada_b = A.in[4];
    const float* norm_attn_g = A.in[5]; const float* w_in = A.in[6]; const float* b_forget = A.in[7]; const float* dsa_g = A.in[8]; const float* fox_g = A.in[9];
    const float* w_out = A.in[10]; const float* norm_ffn_g = A.in[11]; const float* w_gate = A.in[12]; const float* w_up = A.in[13]; const float* w_down = A.in[14]; const float* final_g = A.in[15];

    if (IN(0)) { PHASE_IDS
        LAS float* scr = (LAS float*)(lds + wave * 16384);
        constexpr int I_IN = 106 * 16, I_OUT = 32 * 16, I_G = 88 * 16, I_D = 32 * 44, NITEMS = I_IN + I_OUT + 2 * I_G + I_D;
        for (int it = gw; it < NITEMS; it += NGW) {
            int r = it;
            if (r < I_IN) { const int nb = r >> 4, kb = r & 15; int dst, src;
                if (nb < 48) { dst = 32 * nb; src = 32 * nb; } else if (nb < 96) { dst = 1536 + 32 * (nb - 48); src = C_QF + 32 * (nb - 48); }
                else if (nb < 104) { dst = 3072 + 32 * (nb - 96); src = C_IQ + 32 * (nb - 96); } else { dst = 3328 + 32 * (nb - 104); src = C_IK + 32 * (nb - 104); }
                tr_item(w_in, DIN, D_, src, A.win_t, dst, nullptr, scr, kb, lane); continue; } r -= I_IN;
            if (r < I_OUT) { const int nb = r >> 4, kb = r & 15; tr_item(w_out, D_, D_, 32 * nb, A.wout_t, 32 * nb, (A.pad & 1) ? nullptr : (kb < 8 ? dsa_g : fox_g - 512), scr, kb, lane); continue; } r -= I_OUT;
            if (r < I_G) { const int nb = r >> 4, kb = r & 15; tr_item(w_gate, DFF, D_, 32 * nb, A.wgu_t, 256 * (nb >> 2) + 32 * (nb & 3), nullptr, scr, kb, lane); continue; } r -= I_G;
            if (r < I_G) { const int nb = r >> 4, kb = r & 15; tr_item(w_up, DFF, D_, 32 * nb, A.wgu_t, 256 * (nb >> 2) + 128 + 32 * (nb & 3), nullptr, scr, kb, lane); continue; } r -= I_G;
            { const int nb = r / 44, kb = r % 44; tr_item(w_down, D_, DFF, 32 * nb, A.wd_t, 32 * nb, nullptr, scr, kb, lane); }
        }
        for (int e = vcu * NTHR + tid; e < 192 * D_; e += G * NTHR) { const int np = 64 + e / D_, k = e % D_;
            const int src = (np < 68) ? C_IW + np - 64 : (np >= 72 && np < 80) ? C_FG + np - 72 : -1;
            A.win_t[(size_t)(3328 + np) * D_ + k] = src >= 0 ? (f16)w_in[(size_t)k * DIN + src] : (f16)0.f; }
        for (int e = vcu * NTHR + tid; e < M_ * 8; e += G * NTHR) { const int row = e >> 3, i = e & 7;
            const float inv = (float)pow(500000.0, -(double)i / 8.0); const float angf = (float)positions[row] * inv;
            A.rope[2 * e] = (float)cos((double)angf); A.rope[2 * e + 1] = (float)sin((double)angf); }
        __syncthreads();
        for (int slot = vcu; slot < NMOD / 32; slot += G) {
            LAS float* ca = (LAS float*)lds; LAS float* red = ca + 8192;
            for (int i = tid; i < 8192; i += NTHR) { const float v = cvec[i]; ca[i] = v / (1.f + expf(-v)); }
            __syncthreads();
            const int kg = tid >> 5, cc = tid & 31, n = slot * 32 + cc;
            float acc[8];
#pragma unroll
            for (int b = 0; b < 8; ++b) acc[b] = 0.f;
            for (int k = kg; k < D_; k += 16) { const float w = ada_w[(size_t)k * NMOD + n];
#pragma unroll
                for (int b = 0; b < 8; ++b) acc[b] += ca[b * 1024 + k] * w; }
#pragma unroll
            for (int b = 0; b < 8; ++b) red[(kg * 8 + b) * 32 + cc] = acc[b];
            __syncthreads();
            if (tid < 256) { const int b = tid >> 5; float s = 0.f;
#pragma unroll
                for (int k2 = 0; k2 < 16; ++k2) s += red[(k2 * 8 + b) * 32 + cc];
                A.mod[b * NMOD + n] = s + ada_b[n]; }
            __syncthreads();
        }
        if (BOTH(0)) GRID_BAR();
    }
    if (IN(1)) { PHASE_IDS norm_rows<true, true>(x, norm_attn_g, A.mod, 0, 1024, A.h, nullptr, gw, NGW, lane); if (BOTH(1)) GRID_BAR(); }
    if (IN(2)) { PHASE_IDS
        pg8::Gemm g{(const pg8::bf16_t*)A.h, (const pg8::bf16_t*)A.win_t, M_, NPROJ, D_}; pg8::StaticOrder S; S.init(M_, NPROJ, G, bx);
        EpiProj E{A.qd, A.kd, A.vd, A.qf, A.kf, A.vf, A.iq, A.ik, A.iw, A.logf, A.rope, b_forget};
        pg8::gemm_phase<EpiProj, pg8::StaticOrder, true, true>(lds, g, S, E);
        if (BOTH(2)) GRID_BAR();
    }
    if (IN(3)) { PHASE_IDS
        (void)tid;
        for (int uid = vcu; uid < 1024; uid += G) { const int v = uid & 255, i = uid >> 8, sb = v >> 5, s5 = v & 31; const int qt = (i == 0) ? s5 : (i == 1) ? 63 - s5 : (i == 2) ? 64 + s5 : 127 - s5;
            sel::select_unit(A.iq, A.ik, A.iw, (unsigned short*)A.mask, sb, qt, lds, wave); }
        if (BOTH(3)) GRID_BAR();
    }
    if (IN(4)) { PHASE_IDS
        char* shm = (char*)lds_raw;
        for (int uid = vcu; uid < 1024; uid += G) { const int v = uid & 255, i = uid >> 8, bh = v >> 2, s4 = v & 3; const int qb = (i == 0) ? s4 : (i == 1) ? 7 - s4 : (i == 2) ? 8 + s4 : 15 - s4;
            attn_body::attn_unit<8, 1>(bh >> 3, bh & 7, qb, A.qd, A.kd, A.vd, A.o, A.ssq, 0, nullptr, A.mask, shm); }
        LAS float* biasL = (LAS float*)(lds + 86016); LAS float* wtot = biasL + 4096; int cur_bh = -1;
        for (int uid = vcu; uid < 1024; uid += G) { const int v = uid & 255, i = uid >> 8, bh = v >> 2, s4 = v & 3; const int qb = (i == 0) ? s4 : (i == 1) ? 7 - s4 : (i == 2) ? 8 + s4 : 15 - s4;
            if (bh != cur_bh) {
                cur_bh = bh; __syncthreads();
                int tl = threadIdx.x; asm volatile("" : "+v"(tl)); const int ln = tl & 63;
                const int base = tl * 8; float pv[8]; float run = 0.f;
#pragma unroll
                for (int e = 0; e < 8; ++e) { run += A.logf[(size_t)((bh >> 3) * S_ + base + e) * 8 + (bh & 7)]; pv[e] = run; }
                float incl = run;
#pragma unroll
                for (int o = 1; o < 64; o <<= 1) { const int src = ln - o; const float y = __int_as_float(__builtin_amdgcn_ds_bpermute((src < 0 ? ln : src) << 2, __float_as_int(incl))); if (ln >= o) incl += y; }
                if (ln == 63) wtot[wave] = incl;
                __syncthreads();
                float woff = 0.f; for (int w2 = 0; w2 < wave; ++w2) woff += wtot[w2];
                const float excl = woff + incl - run;
#pragma unroll
                for (int e = 0; e < 8; ++e) biasL[base + e] = -(excl + pv[e]) * 1.4426950408889634f;
                __syncthreads();
            }
            attn_body::attn_unit<8, 0>(bh >> 3, bh & 7, qb, A.qf, A.kf, A.vf, A.o, A.ssq, 1, (attn_body::lds_cfptr)biasL, nullptr, shm); }
        if (BOTH(4)) GRID_BAR();
    }
    if (IN(5)) { PHASE_IDS
        for (int grp = gw; grp < M_ / 16; grp += NGW) {
            for (int r = 0; r < 16; ++r) { const int row = grp * 16 + r;
                float sv = A.ssq[(size_t)(lane & 15) * M_ + row];
                sv += __shfl_xor(sv, 1); sv += __shfl_xor(sv, 2); sv += __shfl_xor(sv, 4);
                const float rd = 1.0f / sqrtf(__shfl(sv, 0) * (1.0f / 512.f) + RMS_EPS), rf = 1.0f / sqrtf(__shfl(sv, 8) * (1.0f / 512.f) + RMS_EPS);
#pragma unroll
                for (int j = 0; j < 2; ++j) { const int ch = lane + 64 * j; GAS v4u* p = (GAS v4u*)(A.o + (size_t)row * D_) + ch; const v4u w = *p; const float rs = ch < 64 ? rd : rf;
                    typedef _Float16 h2 __attribute__((ext_vector_type(2)));
                    v4u o;
#pragma unroll
                    for (int e = 0; e < 4; ++e) { const unsigned we = w[e]; const h2 hv = __builtin_bit_cast(h2, we); o[e] = pkh((float)hv[0] * rs, (float)hv[1] * rs); }
                    *p = o; }
            }
        }
        if (BOTH(5)) GRID_BAR();
    }
    if (IN(6)) { PHASE_IDS
        pg8::Gemm g{(const pg8::bf16_t*)A.o, (const pg8::bf16_t*)A.wout_t, M_, D_, D_}; pg8::StaticOrder S; S.init(M_, D_, G, bx);
        EpiRes E{x, A.out, A.mod + 2048};
        pg8::gemm_phase<EpiRes, pg8::StaticOrder, true, true>(lds, g, S, E);
        if (BOTH(6)) GRID_BAR();
    }
    if (IN(7)) { PHASE_IDS norm_rows<true, true>(A.out, norm_ffn_g, A.mod, 3072, 4096, A.h, nullptr, gw, NGW, lane); if (BOTH(7)) GRID_BAR(); }
    if (IN(8)) { PHASE_IDS
        pg8::Gemm g{(const pg8::bf16_t*)A.h, (const pg8::bf16_t*)A.wgu_t, M_, 2 * DFF, D_}; pg8::StaticOrder S; S.init(M_, 2 * DFF, G, bx);
        EpiGateUp E{A.act};
        pg8::gemm_phase<EpiGateUp, pg8::StaticOrder, true, true>(lds, g, S, E);
        if (BOTH(8)) GRID_BAR();
    }
    if (IN(9)) { PHASE_IDS
        pg8::Gemm g{(const pg8::bf16_t*)A.act, (const pg8::bf16_t*)A.wd_t, M_, D_, DFF}; pg8::StaticOrder S; S.init(M_, D_, G, bx);
        EpiRes E{A.out, A.out, A.mod + 5120};
        pg8::gemm_phase<EpiRes, pg8::StaticOrder, true, true>(lds, g, S, E);
        if (BOTH(9)) GRID_BAR();
    }
    if (IN(10)) { PHASE_IDS norm_rows<false, false>(A.out, final_g, nullptr, 0, 0, nullptr, A.out, gw, NGW, lane); }
#undef IN
#undef BOTH
#undef GRID_BAR
}
__device__ __forceinline__ void mask_pos(int s, int& hw, int& bit) { const int j = s >> 5, w = s & 31, hi = (w >> 2) & 1; bit = (w & 3) | ((w >> 3) << 2); hw = (((j >> 1) * 2 + hi) * 2 + (j & 1)); }

__global__ void __launch_bounds__(64) nk_cumsum2(const float* logf, float* cum) {
    const int b = blockIdx.x >> 3, h = blockIdx.x & 7, l = threadIdx.x;
    const float* src = logf + (size_t)(b * S_ + 64 * l) * 8 + h;
    double s = 0.0;
    for (int i = 0; i < 64; ++i) s += (double)src[(size_t)i * 8];
    double incl = s;
    for (int o = 1; o < 64; o <<= 1) { const double v = __shfl_up(incl, o); if (l >= o) incl += v; }
    double run = incl - s;
    for (int i = 0; i < 64; ++i) { run += (double)src[(size_t)i * 8]; cum[(size_t)(b * S_ + 64 * l + i) * 8 + h] = (float)run; }
}

__global__ void __launch_bounds__(256) nk_select2(const f16* iqb, const f16* ikb, const float* iwb, unsigned short* mask) {
    __shared__ float iq[256]; __shared__ float iw[4]; __shared__ unsigned key[4096]; __shared__ unsigned hist[256]; __shared__ int sh_bin, sh_kk; __shared__ unsigned cnt[256]; __shared__ unsigned char sel[4096];
    const int t = blockIdx.x, b = blockIdx.y, tid = threadIdx.x, row = b * S_ + t, n = t + 1;
    unsigned short* mrow = mask + (size_t)row * 256;
    if (n <= 256) { for (int i = 0; i < 16; ++i) sel[tid * 16 + i] = (tid * 16 + i) < n ? 1 : 0; }
    else {
    iq[tid] = (float)iqb[(size_t)row * 256 + tid]; if (tid < 4) iw[tid] = iwb[(size_t)row * 4 + tid];
    __syncthreads();
#pragma unroll 1
    for (int s = tid; s < n; s += 256) {
        asm volatile("" ::: "memory");
        const f16* kr = ikb + (size_t)(b * S_ + s) * 64;
        float d[4] = {0.f, 0.f, 0.f, 0.f};
#pragma unroll
        for (int j = 0; j < 64; ++j) { const float kv = (float)kr[j];
#pragma unroll
            for (int h = 0; h < 4; ++h) d[h] += iq[h * 64 + j] * kv; }
        float sc = 0.f;
#pragma unroll
        for (int h = 0; h < 4; ++h) sc += fmaxf(d[h] * 0.125f, 0.f) * iw[h];
        key[s] = mono_key(sc);
    }
    __syncthreads();
    unsigned prefix = 0u, pmask = 0u; int kk = 256;
    for (int shift = 24; shift >= 0; shift -= 8) {
        hist[tid] = 0u; __syncthreads();
        for (int s = tid; s < n; s += 256) { const unsigned k = key[s]; if ((k & pmask) == prefix) atomicAdd(&hist[(k >> shift) & 255u], 1u); }
        __syncthreads();
        if (tid == 0) { int c = 0, bin = 255; while (bin > 0 && c + (int)hist[bin] < kk) { c += (int)hist[bin]; --bin; } sh_bin = bin; sh_kk = kk - c; }
        __syncthreads();
        prefix |= (unsigned)sh_bin << shift; pmask |= 255u << shift; kk = sh_kk;
        __syncthreads();
    }
    unsigned ceq = 0u;
    for (int i = 0; i < 16; ++i) { const int s = tid * 16 + i; if (s < n && key[s] == prefix) ++ceq; }
    cnt[tid] = ceq; __syncthreads();
    unsigned before = 0u; for (int j = 0; j < tid; ++j) before += cnt[j];
    for (int i = 0; i < 16; ++i) { const int s = tid * 16 + i; unsigned char v = 0; if (s < n) { const unsigned k = key[s];
        if (k > prefix) v = 1; else if (k == prefix) { if ((int)before < kk) v = 1; ++before; } } sel[s] = v; }
    }
    __syncthreads();
    { const int hw = tid, J = hw >> 2, hi = (hw >> 1) & 1, j = 2 * J + (hw & 1); unsigned bits = 0u;
      for (int r = 0; r < 16; ++r) { const int s = 32 * j + (r & 3) + 8 * (r >> 2) + 4 * hi; if (sel[s]) bits |= 1u << r; }
      mrow[hw] = (unsigned short)bits; }
}

template <int MODE> __global__ void __launch_bounds__(256) nk_attn2(const f16* Q, const f16* K, const f16* V, const float* cum, const unsigned short* mask, float* o, int ooff) {
    __shared__ float lg[4096]; __shared__ float qs[64]; __shared__ float red[256];
    const int t = blockIdx.x, h = blockIdx.y, b = blockIdx.z, tid = threadIdx.x, row = b * S_ + t, n = t + 1;
    if (tid < 64) qs[tid] = (float)Q[(size_t)row * 512 + h * 64 + tid];
    __syncthreads();
    const float cq = (MODE == 0) ? cum[(size_t)row * 8 + h] : 0.f;
    float mx = -INFINITY;
    for (int s = tid; s < n; s += 256) {
        const f16* kr = K + (size_t)(b * S_ + s) * 512 + h * 64;
        float d = 0.f;
#pragma unroll
        for (int j = 0; j < 64; ++j) d += qs[j] * (float)kr[j];
        d *= 0.6931471805599453f;
        if (MODE == 0) d += cq - cum[(size_t)(b * S_ + s) * 8 + h];
        else { int hw, bit; mask_pos(s, hw, bit); if (!((mask[(size_t)row * 256 + hw] >> bit) & 1u)) d = -INFINITY; }
        lg[s] = d; mx = fmaxf(mx, d);
    }
    __syncthreads();
    mx = block_max256(mx, red);
    float sum = 0.f;
    for (int s = tid; s < n; s += 256) { const float p = expf(lg[s] - mx); lg[s] = p; sum += p; }
    __syncthreads();
    sum = block_sum256(sum, red);
    const int d = tid & 63, g = tid >> 6; float acc = 0.f;
    for (int s = g; s < n; s += 4) acc += lg[s] * (float)V[(size_t)(b * S_ + s) * 512 + h * 64 + d];
    red[tid] = acc; __syncthreads();
    if (tid < 64) o[(size_t)row * D_ + ooff + h * 64 + tid] = (red[tid] + red[tid + 64] + red[tid + 128] + red[tid + 192]) / sum;
}

__global__ void __launch_bounds__(256) nk_o_bridge(const float* o, f16* O, float* ssq) {
    __shared__ float red[256];
    const int row = blockIdx.x, tid = threadIdx.x;
    float s = 0.f;
    for (int i = 0; i < 4; ++i) { const int c = tid * 4 + i; const f16 hv = (f16)o[(size_t)row * D_ + c]; O[(size_t)row * D_ + c] = hv; const float f = (float)hv; s += f * f; }
    red[tid] = s; __syncthreads();
    if (tid < 16) { float a = 0.f; for (int j = 0; j < 16; ++j) a += red[tid * 16 + j]; ssq[(size_t)tid * M_ + row] = a; }
}
static int fwd_grid() {
    static int grid = 0;
    if (grid == 0) {
        int dev = 0, cus = 0, per_cu = 0;
        if (hipGetDevice(&dev) != hipSuccess || hipDeviceGetAttribute(&cus, hipDeviceAttributeMultiprocessorCount, dev) != hipSuccess) { fprintf(stderr, "kernel_launch: device query failed\n"); grid = -1; return grid; }
        if (hipFuncSetAttribute((const void*)fwd, hipFuncAttributeMaxDynamicSharedMemorySize, LDS_BYTES) != hipSuccess) { fprintf(stderr, "kernel_launch: hipFuncSetAttribute failed\n"); grid = -1; return grid; }
        if (hipOccupancyMaxActiveBlocksPerMultiprocessor(&per_cu, (const void*)fwd, NTHR, LDS_BYTES) != hipSuccess || per_cu < 1) fprintf(stderr, "kernel_launch: occupancy query reports %d blocks per CU\n", per_cu);
        (void)hipGetLastError();
        grid = cus;
    }
    return grid;
}
static void launch_fwd(FArgs a, int lo, int hi, int li, int grid, hipStream_t stream) {
    a.ph_lo = lo; a.ph_hi = hi; a.li = li; a.pad = 0;
    hipLaunchKernelGGL(fwd, dim3(grid), dim3(NTHR), LDS_BYTES, stream, a);
}
static void fill_args(FArgs& a, void* const* d_in, void* d_out, unsigned char* ws) {
    memset(&a, 0, sizeof(a));
    for (int i = 0; i < 16; ++i) a.in[i] = (const float*)d_in[i];
    a.out = (float*)d_out; a.ctl = (unsigned*)(ws); a.mod = (float*)(ws + 1 * MiB); a.rope = (float*)(ws + 2 * MiB);
    a.win_t = (f16*)(ws + 4 * MiB); a.wout_t = (f16*)(ws + 11 * MiB); a.wgu_t = (f16*)(ws + 13 * MiB); a.wd_t = (f16*)(ws + 24 * MiB);
    a.iw = (float*)(ws + 30 * MiB); a.logf = (float*)(ws + 31 * MiB); a.mask = (unsigned*)(ws + 32 * MiB); a.ssq = (float*)(ws + 48 * MiB);
    a.iq = (f16*)(ws + 50 * MiB); a.ik = (f16*)(ws + 66 * MiB); a.h = (f16*)(ws + 70 * MiB); a.o = (f16*)(ws + 134 * MiB);
    a.qd = (f16*)(ws + 198 * MiB); a.kd = (f16*)(ws + 230 * MiB); a.vd = (f16*)(ws + 262 * MiB); a.qf = (f16*)(ws + 294 * MiB); a.kf = (f16*)(ws + 326 * MiB); a.vf = (f16*)(ws + 358 * MiB);
    a.act = (f16*)(ws + 198 * MiB);
}

extern "C" void kernel_launch(void* const* d_in, const int* in_sizes, int n_in, void* d_out, int out_size, void* d_ws, size_t ws_size, hipStream_t stream) {
    if (ws_size < 512 * MiB || n_in != 16 || out_size != M_ * D_) { fprintf(stderr, "kernel_launch: unexpected sizes ws %zu n_in %d out %d\n", ws_size, n_in, out_size); return; }
    const int grid = fwd_grid(); if (grid < 0) return;
    unsigned char* ws = (unsigned char*)d_ws; float* out = (float*)d_out;
    FArgs a; fill_args(a, d_in, d_out, ws);
    hipMemsetAsync(a.ctl, 0, 1 * MiB, stream);
    launch_fwd(a, 0, 11, 0, grid, stream);
}
```

```cpp
#include <hip/hip_runtime.h>
#include <cstdio>
#include <cstdint>
#include <cmath>
#include <cstring>

constexpr int B_ = 8, S_ = 4096, D_ = 1024, M_ = B_ * S_, DIN = 3404, DFF = 2816, NMOD = 6144;
constexpr int C_QD = 0, C_KD = 512, C_VD = 1024, C_IQ = 1536, C_IK = 1792, C_IW = 1856, C_QF = 1860, C_KF = 2372, C_VF = 2884, C_FG = 3396;
constexpr float RMS_EPS = 1e-6f;

__device__ __forceinline__ float block_sum256(float v, float* red) {
    const int tid = threadIdx.x;
    red[tid] = v; __syncthreads();
    for (int o = 128; o > 0; o >>= 1) { if (tid < o) red[tid] += red[tid + o]; __syncthreads(); }
    const float r = red[0]; __syncthreads(); return r;
}
__device__ __forceinline__ float block_max256(float v, float* red) {
    const int tid = threadIdx.x;
    red[tid] = v; __syncthreads();
    for (int o = 128; o > 0; o >>= 1) { if (tid < o) red[tid] = fmaxf(red[tid], red[tid + o]); __syncthreads(); }
    const float r = red[0]; __syncthreads(); return r;
}

__global__ void __launch_bounds__(256) nk_mod(const float* c, const float* aw, const float* ab, float* mod) {
    __shared__ float ca[8][1024];
    const int tid = threadIdx.x, n = blockIdx.x * 256 + tid;
    for (int i = tid; i < 8192; i += 256) { const float v = c[i]; ca[i >> 10][i & 1023] = v / (1.f + expf(-v)); }
    __syncthreads();
    float acc[8];
#pragma unroll
    for (int b = 0; b < 8; ++b) acc[b] = 0.f;
    for (int k = 0; k < 1024; ++k) { const float w = aw[(size_t)k * NMOD + n];
#pragma unroll
        for (int b = 0; b < 8; ++b) acc[b] += ca[b][k] * w; }
#pragma unroll
    for (int b = 0; b < 8; ++b) mod[b * NMOD + n] = acc[b] + ab[n];
}

__global__ void __launch_bounds__(256) nk_norm_mod(const float* x, const float* g, const float* mod, int sh_off, int sc_off, float* out) {
    __shared__ float red[256];
    const int row = blockIdx.x, tid = threadIdx.x, b = row / S_;
    const float4 v = ((const float4*)(x + (size_t)row * D_))[tid];
    const float ss = block_sum256(v.x * v.x + v.y * v.y + v.z * v.z + v.w * v.w, red);
    const float rstd = 1.0f / sqrtf(ss * (1.0f / D_) + RMS_EPS);
    const float4 gg = ((const float4*)g)[tid];
    float4 o = {v.x * rstd * gg.x, v.y * rstd * gg.y, v.z * rstd * gg.z, v.w * rstd * gg.w};
    if (mod) {
        const float4 sc = ((const float4*)(mod + b * NMOD + sc_off))[tid], sh = ((const float4*)(mod + b * NMOD + sh_off))[tid];
        o.x = o.x * (1.f + sc.x) + sh.x; o.y = o.y * (1.f + sc.y) + sh.y; o.z = o.z * (1.f + sc.z) + sh.z; o.w = o.w * (1.f + sc.w) + sh.w;
    }
    ((float4*)(out + (size_t)row * D_))[tid] = o;
}

enum { EPI_PLAIN = 0, EPI_RES = 1, EPI_GATEUP = 2 };
struct GemmArgs { const float* A; const float* W; const float* W2; float* C; const float* base; const float* mod; int lda, ldw, M, N, K, ldc, g_off, pad; };
static GemmArgs mk_gemm(const float* A, int lda, const float* W, const float* W2, int ldw, int M, int N, int K, float* C, int ldc, const float* base, const float* mod, int g_off) {
    GemmArgs g; memset(&g, 0, sizeof(g)); g.A = A; g.W = W; g.W2 = W2; g.C = C; g.base = base; g.mod = mod; g.lda = lda; g.ldw = ldw; g.M = M; g.N = N; g.K = K; g.ldc = ldc; g.g_off = g_off; g.pad = 0; return g; }
template <int EPI> __global__ void __launch_bounds__(256) nk_gemm(GemmArgs a) {
    __shared__ float As[16][65];
    __shared__ float Ws[16][64];
    __shared__ float Ws2[EPI == EPI_GATEUP ? 16 : 1][64];
    const int tid = threadIdx.x, tx = tid & 15, ty = tid >> 4, m0 = blockIdx.y * 64, n0 = blockIdx.x * 64;
    float acc[4][4], acc2[4][4];
#pragma unroll
    for (int i = 0; i < 4; ++i)
#pragma unroll
        for (int j = 0; j < 4; ++j) { acc[i][j] = 0.f; acc2[i][j] = 0.f; }
    for (int k0 = 0; k0 < a.K; k0 += 16) {
#pragma unroll
        for (int i = 0; i < 4; ++i) { const int idx = tid + i * 256, r = idx >> 4, kk = idx & 15; As[kk][r] = a.A[(size_t)(m0 + r) * a.lda + k0 + kk]; }
#pragma unroll
        for (int i = 0; i < 4; ++i) { const int idx = tid + i * 256, kk = idx >> 6, c = idx & 63; const bool ok = (n0 + c) < a.N;
            Ws[kk][c] = ok ? a.W[(size_t)(k0 + kk) * a.ldw + n0 + c] : 0.f;
            if (EPI == EPI_GATEUP) Ws2[kk][c] = ok ? a.W2[(size_t)(k0 + kk) * a.ldw + n0 + c] : 0.f; }
        __syncthreads();
#pragma unroll
        for (int kk = 0; kk < 16; ++kk) {
            float av[4], bv[4], bv2[4];
#pragma unroll
            for (int i = 0; i < 4; ++i) av[i] = As[kk][ty * 4 + i];
#pragma unroll
            for (int j = 0; j < 4; ++j) { bv[j] = Ws[kk][tx * 4 + j]; if (EPI == EPI_GATEUP) bv2[j] = Ws2[kk][tx * 4 + j]; }
#pragma unroll
            for (int i = 0; i < 4; ++i)
#pragma unroll
                for (int j = 0; j < 4; ++j) { acc[i][j] += av[i] * bv[j]; if (EPI == EPI_GATEUP) acc2[i][j] += av[i] * bv2[j]; }
        }
        __syncthreads();
    }
#pragma unroll
    for (int i = 0; i < 4; ++i) { const int row = m0 + ty * 4 + i, b = row / S_;
#pragma unroll
        for (int j = 0; j < 4; ++j) { const int col = n0 + tx * 4 + j; if (col >= a.N) continue;
            float v = acc[i][j];
            if (EPI == EPI_RES) v = a.base[(size_t)row * a.ldc + col] + a.mod[b * NMOD + a.g_off + col] * v;
            if (EPI == EPI_GATEUP) { const float gq = v; v = gq / (1.f + expf(-gq)) * acc2[i][j]; }
            a.C[(size_t)row * a.ldc + col] = v; } }
}

__global__ void __launch_bounds__(192) nk_post_proj(float* proj, const int* positions, const float* bfg) {
    const int row = blockIdx.x, t = threadIdx.x; float* p = proj + (size_t)row * DIN;
    const int pos = positions[row];
    if (t < 168) { const int hh = t >> 3, i = t & 7;
        const int base = hh < 8 ? C_QD + hh * 64 : hh < 16 ? C_KD + (hh - 8) * 64 : hh < 20 ? C_IQ + (hh - 16) * 64 : C_IK;
        const float inv = (float)pow(500000.0, -(double)i / 8.0);
        const float angf = (float)pos * inv;
        const float c = (float)cos((double)angf), s = (float)sin((double)angf);
        const float x1 = p[base + i], x2 = p[base + 8 + i];
        p[base + i] = x1 * c - x2 * s; p[base + 8 + i] = x2 * c + x1 * s;
    } else if (t < 172) { p[C_IW + t - 168] *= 0.5f; }
    else if (t < 180) { const int h = t - 172; const float z = p[C_FG + h] + bfg[h]; p[C_FG + h] = fminf(z, 0.f) - log1pf(expf(-fabsf(z))); }
}

__global__ void __launch_bounds__(64) nk_cumsum(const float* proj, float* cum) {
    const int b = blockIdx.x >> 3, h = blockIdx.x & 7, l = threadIdx.x;
    const float* src = proj + (size_t)(b * S_ + 64 * l) * DIN + C_FG + h;
    double s = 0.0;
    for (int i = 0; i < 64; ++i) s += (double)src[(size_t)i * DIN];
    double incl = s;
    for (int o = 1; o < 64; o <<= 1) { const double v = __shfl_up(incl, o); if (l >= o) incl += v; }
    double run = incl - s;
    for (int i = 0; i < 64; ++i) { run += (double)src[(size_t)i * DIN]; cum[(size_t)(b * S_ + 64 * l + i) * 8 + h] = (float)run; }
}

__device__ __forceinline__ unsigned mono_key(float f) { const unsigned u = __float_as_uint(f); return (u & 0x80000000u) ? ~u : (u | 0x80000000u); }

__global__ void __launch_bounds__(256) nk_select(const float* proj, unsigned* mask) {
    __shared__ float iq[256]; __shared__ float iw[4]; __shared__ unsigned key[4096]; __shared__ unsigned hist[256]; __shared__ int sh_bin, sh_kk; __shared__ unsigned cnt[256]; __shared__ unsigned short half[256];
    const int t = blockIdx.x, b = blockIdx.y, tid = threadIdx.x, row = b * S_ + t, n = t + 1;
    unsigned* mrow = mask + (size_t)row * 128;
    if (n <= 256) { if (tid < 128) { const int lo = tid * 32; unsigned w = 0u; if (n >= lo + 32) w = 0xffffffffu; else if (n > lo) w = (1u << (n - lo)) - 1u; mrow[tid] = w; } return; }
    iq[tid] = proj[(size_t)row * DIN + C_IQ + tid]; if (tid < 4) iw[tid] = proj[(size_t)row * DIN + C_IW + tid];
    __syncthreads();
#pragma unroll 1
    for (int s = tid; s < n; s += 256) {
        asm volatile("" ::: "memory");
        const float4* kr = (const float4*)(proj + (size_t)(b * S_ + s) * DIN + C_IK);
        float d[4] = {0.f, 0.f, 0.f, 0.f};
#pragma unroll
        for (int j = 0; j < 16; ++j) { const float4 k4 = kr[j];
#pragma unroll
            for (int h = 0; h < 4; ++h) d[h] += iq[h * 64 + 4 * j] * k4.x + iq[h * 64 + 4 * j + 1] * k4.y + iq[h * 64 + 4 * j + 2] * k4.z + iq[h * 64 + 4 * j + 3] * k4.w; }
        float sc = 0.f;
#pragma unroll
        for (int h = 0; h < 4; ++h) sc += fmaxf(d[h] * 0.125f, 0.f) * iw[h];
        key[s] = mono_key(sc);
    }
    __syncthreads();
    unsigned prefix = 0u, pmask = 0u; int kk = 256;
    for (int shift = 24; shift >= 0; shift -= 8) {
        hist[tid] = 0u; __syncthreads();
        for (int s = tid; s < n; s += 256) { const unsigned k = key[s]; if ((k & pmask) == prefix) atomicAdd(&hist[(k >> shift) & 255u], 1u); }
        __syncthreads();
        if (tid == 0) { int c = 0, bin = 255; while (bin > 0 && c + (int)hist[bin] < kk) { c += (int)hist[bin]; --bin; } sh_bin = bin; sh_kk = kk - c; }
        __syncthreads();
        prefix |= (unsigned)sh_bin << shift; pmask |= 255u << shift; kk = sh_kk;
        __syncthreads();
    }
    unsigned ceq = 0u;
    for (int i = 0; i < 16; ++i) { const int s = tid * 16 + i; if (s < n && key[s] == prefix) ++ceq; }
    cnt[tid] = ceq; __syncthreads();
    unsigned before = 0u; for (int j = 0; j < tid; ++j) before += cnt[j];
    unsigned bits = 0u;
    for (int i = 0; i < 16; ++i) { const int s = tid * 16 + i; if (s < n) { const unsigned k = key[s];
        if (k > prefix) bits |= 1u << i; else if (k == prefix) { if ((int)before < kk) bits |= 1u << i; ++before; } } }
    half[tid] = (unsigned short)bits; __syncthreads();
    if (tid < 128) mrow[tid] = (unsigned)half[2 * tid] | ((unsigned)half[2 * tid + 1] << 16);
}

template <int MODE> __global__ void __launch_bounds__(256) nk_attn(const float* proj, int qoff, int koff, int voff, const float* cum, const unsigned* mask, float* o, int ooff) {
    __shared__ float lg[4096]; __shared__ float qs[64]; __shared__ float red[256];
    const int t = blockIdx.x, h = blockIdx.y, b = blockIdx.z, tid = threadIdx.x, row = b * S_ + t, n = t + 1;
    if (tid < 64) qs[tid] = proj[(size_t)row * DIN + qoff + h * 64 + tid];
    __syncthreads();
    const float cq = (MODE == 0) ? cum[(size_t)row * 8 + h] : 0.f;
    float mx = -INFINITY;
    for (int s = tid; s < n; s += 256) {
        const float4* kr = (const float4*)(proj + (size_t)(b * S_ + s) * DIN + koff + h * 64);
        float d = 0.f;
#pragma unroll
        for (int j = 0; j < 16; ++j) { const float4 k4 = kr[j]; d += qs[4 * j] * k4.x + qs[4 * j + 1] * k4.y + qs[4 * j + 2] * k4.z + qs[4 * j + 3] * k4.w; }
        d *= 0.125f;
        if (MODE == 0) d += cq - cum[(size_t)(b * S_ + s) * 8 + h];
        else { if (!((mask[(size_t)row * 128 + (s >> 5)] >> (s & 31)) & 1u)) d = -INFINITY; }
        lg[s] = d; mx = fmaxf(mx, d);
    }
    __syncthreads();
    mx = block_max256(mx, red);
    float sum = 0.f;
    for (int s = tid; s < n; s += 256) { const float p = expf(lg[s] - mx); lg[s] = p; sum += p; }
    __syncthreads();
    sum = block_sum256(sum, red);
    const int d = tid & 63, g = tid >> 6; float acc = 0.f;
    for (int s = g; s < n; s += 4) acc += lg[s] * proj[(size_t)(b * S_ + s) * DIN + voff + h * 64 + d];
    red[tid] = acc; __syncthreads();
    if (tid < 64) o[(size_t)row * D_ + ooff + h * 64 + tid] = (red[tid] + red[tid + 64] + red[tid + 128] + red[tid + 192]) / sum;
}

__global__ void __launch_bounds__(256) nk_group_norm(float* o, const float* gd, const float* gf) {
    __shared__ float red[256];
    const int row = blockIdx.x, tid = threadIdx.x, grp = tid >> 7, li = tid & 127;
    float4* p = (float4*)(o + (size_t)row * D_ + grp * 512) + li;
    const float4 v = *p;
    red[tid] = v.x * v.x + v.y * v.y + v.z * v.z + v.w * v.w; __syncthreads();
    for (int off = 64; off > 0; off >>= 1) { if (li < off) red[tid] += red[tid + off]; __syncthreads(); }
    const float rstd = 1.0f / sqrtf(red[grp * 128] * (1.0f / 512.f) + RMS_EPS);
    const float4 g = ((const float4*)(grp ? gf : gd))[li];
    *p = (float4){v.x * rstd * g.x, v.y * rstd * g.y, v.z * rstd * g.z, v.w * rstd * g.w};
}

namespace pg8 {
#define PG8_LAS __attribute__((address_space(3)))
typedef unsigned short bf16_t;
typedef _Float16 bf16x8 __attribute__((ext_vector_type(8)));
typedef float f32x4 __attribute__((ext_vector_type(4)));
typedef unsigned u32x4 __attribute__((ext_vector_type(4)));
constexpr int BM = 256, BK = 64, HALF = 128, HTB = HALF * BK * 2  , STAGE_BYTES = 8 * HTB, NXCD = 8, WGM = 8;

__host__ __device__ __forceinline__ int lds_byte(int r, int c) { const int st = (r >> 4) * 2 + (c >> 5), rr = r & 15, cc = c & 31, ob = rr * 64 + cc * 2; return st * 1024 + (ob ^ (((ob >> 9) & 1) << 5)); }
__host__ __device__ __forceinline__ void stage_rc(int b, int& R, int& C) { const int st = b / 1024, sb = b % 1024, swz = sb ^ (((sb >> 9) & 1) << 5); R = (st >> 1) * 16 + swz / 64; C = (st & 1) * 32 + (swz % 64) / 2; }
__host__ __device__ __forceinline__ int perm32(int rho) { const int n = rho >> 4, i = rho & 15; return 8 * (i >> 2) + 4 * n + (i & 3); }

struct Unit { int pm, pn; };
struct Gemm { const bf16_t* A; const bf16_t* Bt; int M, N, K; };

struct StaticOrder {
    int nM, nN, nwg, G, c;
    __host__ __device__ void init(int M, int N, int G_, int c_) { nM = M / BM; nN = N / BM; nwg = nM * nN; G = G_; c = c_; }
    __host__ __device__ bool next(int i, Unit& u) const {
        const long L = (long)i * G + c; if (L >= nwg) return false;
        int wgid = (int)L; { const int q = nwg / NXCD, r = nwg % NXCD, xcd = wgid % NXCD, off = wgid / NXCD; wgid = (xcd < r ? xcd * (q + 1) : r * (q + 1) + (xcd - r) * q) + off; }
        const int nig = WGM * nN, gid = wgid / nig, fm = gid * WGM, gsz = (nM - fm) < WGM ? (nM - fm) : WGM;
        u.pm = fm + ((wgid % nig) % gsz); u.pn = (wgid % nig) / gsz; return true;
    }
    __device__ __forceinline__ void a_ready(const Unit&) const {}
    __device__ __forceinline__ void done(const Unit&) const {}
};

__device__ __forceinline__ unsigned cvt_pk_f16(float lo, float hi) { typedef float f2_ __attribute__((ext_vector_type(2))); typedef _Float16 h2_ __attribute__((ext_vector_type(2))); f2_ v = {lo, hi}; h2_ h = __builtin_convertvector(v, h2_); return __builtin_bit_cast(unsigned, h); }
template <class Epi, class Sched, bool ALIGN_EPI = false, bool SP2 = false>
__device__ __forceinline__ void gemm_phase(PG8_LAS unsigned char* lds, const Gemm g, const Sched& S, const Epi& E) {
    const int tid = threadIdx.x, wid = __builtin_amdgcn_readfirstlane(tid >> 6), lane = tid & 63, wr = wid >> 2, wc = wid & 3, fr = lane & 15, fq = lane >> 4;
    const int K = g.K, nt = K / BK;
    unsigned voffA[2], voffB[2];
#pragma unroll
    for (int i = 0; i < 2; ++i) { int R, C; stage_rc(tid * 16 + i * 8192, R, C); const int Rb = Epi::PERM ? ((R & ~31) + perm32(R & 31)) : R;
        voffA[i] = (unsigned)(R * K + C) * 2u; voffB[i] = (unsigned)(Rb * K + C) * 2u; }
    const size_t kstep = (size_t)(BK * 2);
    const size_t hstep = (size_t)HALF * K * 2;
    const size_t tstep = 2 * hstep;
    const unsigned ldsw = (unsigned)wid * 1024u;
    const int aoff = lds_byte(wr * 64 + fr, fq * 8), boff = lds_byte(wc * 32 + fr, fq * 8);
#define PG8_SA(b, h) (((b) * 2 + (h)) * HTB)
#define PG8_SB(b, h) ((4 + (b) * 2 + (h)) * HTB)
#define PG8_STAGE(bufoff, gbase, voff) do { _Pragma("unroll") for (int _i = 0; _i < 2; ++_i) \
        __builtin_amdgcn_global_load_lds((const unsigned*)((const char*)(gbase) + (voff)[_i]), (PG8_LAS unsigned*)(lds + (bufoff) + ldsw + _i * 8192), 16, 0, 0); } while (0)
#define PG8_LDA(dst, b, h) do { _Pragma("unroll") for (int m = 0; m < 4; ++m) _Pragma("unroll") for (int k = 0; k < 2; ++k) dst[m][k] = *(const PG8_LAS bf16x8*)(lds + PG8_SA(b, h) + aoff + m * 2048 + k * 1024); } while (0)
#define PG8_LDB(dst, b, h) do { _Pragma("unroll") for (int n = 0; n < 2; ++n) _Pragma("unroll") for (int k = 0; k < 2; ++k) dst[n][k] = *(const PG8_LAS bf16x8*)(lds + PG8_SB(b, h) + boff + n * 2048 + k * 1024); } while (0)
#define PG8_MMA(ai, bj, At, Bt) do { __builtin_amdgcn_s_setprio(1); _Pragma("unroll") for (int m = 0; m < 4; ++m) _Pragma("unroll") for (int n = 0; n < 2; ++n) _Pragma("unroll") for (int k = 0; k < 2; ++k) \
        acc[ai][bj][m][n] = __builtin_amdgcn_mfma_f32_16x16x32_f16(Bt[n][k], At[m][k], acc[ai][bj][m][n], 0, 0, 0); __builtin_amdgcn_s_setprio(0); } while (0)
#define PG8_WAIT_V(n) asm volatile("s_waitcnt vmcnt(" #n ")" ::: "memory")
#define PG8_WAIT_L(n) asm volatile("s_waitcnt lgkmcnt(" #n ")" ::: "memory")
#define PG8_BAR __builtin_amdgcn_s_barrier()
#define PG8_SCHED __builtin_amdgcn_sched_barrier(0)
    Unit cur, nxt; int ui = 0;
    if (!S.next(0, cur)) return;
    f32x4 acc[2][2][4][2];
#pragma unroll
    for (int a = 0; a < 2; ++a)
#pragma unroll
        for (int b = 0; b < 2; ++b)
#pragma unroll
            for (int m = 0; m < 4; ++m)
#pragma unroll
                for (int n = 0; n < 2; ++n) acc[a][b][m][n] = (f32x4){0.f, 0.f, 0.f, 0.f};
    bf16x8 At[4][2], B0[2][2], B1[2][2];
    const char* cA = (const char*)g.A + (size_t)cur.pm * tstep; const char* cB = (const char*)g.Bt + (size_t)cur.pn * tstep;
    S.a_ready(cur);
    if constexpr (SP2) {
        PG8_STAGE(PG8_SB(0, 0), cB, voffB); PG8_STAGE(PG8_SB(0, 1), cB + hstep, voffB); PG8_STAGE(PG8_SA(0, 0), cA, voffA); PG8_STAGE(PG8_SA(0, 1), cA + hstep, voffA);
        if (wr == 1) PG8_BAR;
        PG8_WAIT_V(2); PG8_BAR;
        PG8_STAGE(PG8_SB(1, 0), cB + kstep, voffB); PG8_STAGE(PG8_SA(1, 0), cA + kstep, voffA); PG8_STAGE(PG8_SB(1, 1), cB + hstep + kstep, voffB);
        PG8_WAIT_V(6); PG8_BAR;
    } else {
        PG8_STAGE(PG8_SB(0, 0), cB, voffB); PG8_STAGE(PG8_SA(0, 0), cA, voffA); PG8_STAGE(PG8_SB(0, 1), cB + hstep, voffB); PG8_STAGE(PG8_SA(0, 1), cA + hstep, voffA);
        if (wr == 1) PG8_BAR;
        PG8_WAIT_V(4); PG8_BAR;
        PG8_STAGE(PG8_SB(1, 0), cB + kstep, voffB); PG8_STAGE(PG8_SA(1, 0), cA + kstep, voffA); PG8_STAGE(PG8_SB(1, 1), cB + hstep + kstep, voffB);
        PG8_WAIT_V(6); PG8_BAR;
    }
    for (;;) {
        const bool has_next = S.next(ui + 1, nxt);
        const char* nA = has_next ? (const char*)g.A + (size_t)nxt.pm * tstep : cA; const char* nB = has_next ? (const char*)g.Bt + (size_t)nxt.pn * tstep : cB;
        for (int t = 0; t < nt; t += 2) {
            const bool last = (t == nt - 2);
            const char* a1 = cA + (size_t)(t + 1) * kstep;
            const char* a2 = last ? nA : cA + (size_t)(t + 2) * kstep; const char* b2 = last ? nB : cB + (size_t)(t + 2) * kstep;
            const char* a3 = a2 + kstep; const char* b3 = b2 + kstep;
            if (last && has_next) S.a_ready(nxt);
            if constexpr (SP2) {
            PG8_LDB(B0, 0, 0); PG8_LDB(B1, 0, 1); PG8_SCHED; PG8_LDA(At, 0, 0); PG8_STAGE(PG8_SA(1, 1), a1 + hstep, voffA);
            PG8_WAIT_V(8); PG8_WAIT_L(0); PG8_BAR; PG8_MMA(0, 0, At, B0); PG8_MMA(0, 1, At, B1); PG8_BAR; PG8_SCHED;
            PG8_LDA(At, 0, 1); PG8_STAGE(PG8_SB(0, 0), b2, voffB); PG8_STAGE(PG8_SB(0, 1), b2 + hstep, voffB); PG8_STAGE(PG8_SA(0, 0), a2, voffA);
            PG8_WAIT_V(8); PG8_WAIT_L(0); PG8_BAR; PG8_MMA(1, 0, At, B0); PG8_MMA(1, 1, At, B1); PG8_BAR; PG8_SCHED;
            PG8_LDB(B0, 1, 0); PG8_LDB(B1, 1, 1); PG8_SCHED; PG8_LDA(At, 1, 0); PG8_STAGE(PG8_SA(0, 1), a2 + hstep, voffA);
            PG8_WAIT_V(8); PG8_WAIT_L(0); PG8_BAR; PG8_MMA(0, 0, At, B0); PG8_MMA(0, 1, At, B1); PG8_BAR; PG8_SCHED;
            PG8_LDA(At, 1, 1); PG8_STAGE(PG8_SB(1, 0), b3, voffB); PG8_STAGE(PG8_SB(1, 1), b3 + hstep, voffB); PG8_STAGE(PG8_SA(1, 0), a3, voffA);
            PG8_WAIT_V(8); PG8_WAIT_L(0); PG8_BAR; PG8_MMA(1, 0, At, B0); PG8_MMA(1, 1, At, B1); PG8_BAR; PG8_SCHED;
            } else {
            PG8_LDB(B0, 0, 0); PG8_SCHED; PG8_LDA(At, 0, 0); PG8_STAGE(PG8_SA(1, 1), a1 + hstep, voffA);
            PG8_WAIT_L(8); PG8_BAR; PG8_WAIT_L(0); PG8_MMA(0, 0, At, B0); PG8_BAR; PG8_SCHED;
            PG8_LDB(B1, 0, 1); PG8_STAGE(PG8_SB(0, 0), b2, voffB);
            PG8_BAR; PG8_WAIT_L(0); PG8_MMA(0, 1, At, B1); PG8_BAR;
            PG8_LDA(At, 0, 1); PG8_STAGE(PG8_SA(0, 0), a2, voffA);
            PG8_BAR; PG8_WAIT_L(0); PG8_MMA(1, 0, At, B0); PG8_BAR; PG8_SCHED;
            PG8_STAGE(PG8_SB(0, 1), b2 + hstep, voffB);
            PG8_WAIT_V(6); PG8_BAR; PG8_MMA(1, 1, At, B1); PG8_BAR;
            PG8_LDB(B0, 1, 0); PG8_SCHED; PG8_LDA(At, 1, 0); PG8_STAGE(PG8_SA(0, 1), a2 + hstep, voffA);
            PG8_WAIT_L(8); PG8_BAR; PG8_WAIT_L(0); PG8_MMA(0, 0, At, B0); PG8_BAR; PG8_SCHED;
            PG8_LDB(B1, 1, 1); PG8_STAGE(PG8_SB(1, 0), b3, voffB);
            PG8_BAR; PG8_WAIT_L(0); PG8_MMA(0, 1, At, B1); PG8_BAR;
            PG8_LDA(At, 1, 1); PG8_STAGE(PG8_SA(1, 0), a3, voffA);
            PG8_BAR; PG8_WAIT_L(0); PG8_MMA(1, 0, At, B0); PG8_BAR; PG8_SCHED;
            PG8_STAGE(PG8_SB(1, 1), b3 + hstep, voffB);
            PG8_WAIT_V(6); PG8_BAR; PG8_MMA(1, 1, At, B1); PG8_BAR;
            }
        }
        if constexpr (ALIGN_EPI) { if (wr == 0) PG8_BAR; }
        if constexpr (!Epi::AFTER_DRAIN) { E(acc, cur, wr, wc, fr, fq); S.done(cur); }
        if (!has_next) break;
#pragma unroll
        for (int a = 0; a < 2; ++a)
#pragma unroll
            for (int b = 0; b < 2; ++b)
#pragma unroll
                for (int m = 0; m < 4; ++m)
#pragma unroll
                    for (int n = 0; n < 2; ++n) acc[a][b][m][n] = (f32x4){0.f, 0.f, 0.f, 0.f};
        cur = nxt; cA = nA; cB = nB; ++ui;
        if constexpr (ALIGN_EPI) { if (wr == 1) PG8_BAR; }
    }
    PG8_WAIT_V(0);
    if constexpr (!ALIGN_EPI) { if (wr == 0) PG8_BAR; }
    PG8_BAR;
    if constexpr (Epi::AFTER_DRAIN) { E.fused(acc, cur, wr, wc, fr, fq, lds, wid, lane); S.done(cur); }
#undef PG8_SA
#undef PG8_SB
#undef PG8_STAGE
#undef PG8_LDA
#undef PG8_LDB
#undef PG8_MMA
#undef PG8_WAIT_V
#undef PG8_WAIT_L
#undef PG8_BAR
#undef PG8_SCHED
}
}
#define GAS __attribute__((address_space(1)))
#define LAS __attribute__((address_space(3)))
typedef _Float16 f16;
typedef unsigned v4u __attribute__((ext_vector_type(4)));
typedef unsigned v2u __attribute__((ext_vector_type(2)));
typedef float f32x4 __attribute__((ext_vector_type(4)));
typedef float f32x2 __attribute__((ext_vector_type(2)));
typedef GAS unsigned gu32;
typedef GAS unsigned long long gu64;
#define RLX_AGENT __ATOMIC_RELAXED, __HIP_MEMORY_SCOPE_AGENT
#define LDS_WAIT() asm volatile("s_waitcnt lgkmcnt(0)" ::: "memory")
#define VM_WAIT() asm volatile("s_waitcnt vmcnt(0)" ::: "memory")
__device__ __forceinline__ unsigned pkh(float lo, float hi) { typedef _Float16 h2_ __attribute__((ext_vector_type(2))); f32x2 v = {lo, hi}; h2_ h = __builtin_convertvector(v, h2_); return __builtin_bit_cast(unsigned, h); }
#define XB_TMO      128
#define XB_XCNT(j)  (256  + 64 * (j))
#define XB_XSUB(j)  (1280 + 64 * (j))
#define XB_XGEN(j)  (2304 + 64 * (j))
#define XB_TOP      3328
#define XB_TOPGEN   3392
#define XCD_BAR_WORDS 3456
#define XB_SPIN_CAP (1u << 18)

__device__ __forceinline__ unsigned xb_ld(unsigned* p)              { return __hip_atomic_load(p, __ATOMIC_RELAXED, __HIP_MEMORY_SCOPE_AGENT); }
__device__ __forceinline__ unsigned xb_add(unsigned* p, unsigned v) { return __hip_atomic_fetch_add(p, v, __ATOMIC_RELAXED, __HIP_MEMORY_SCOPE_AGENT); }
__device__ __forceinline__ unsigned xb_xcc_id() { return (unsigned)__builtin_amdgcn_s_getreg((3 << 11) | 20) & 0xFu; }
#define XB_SPIN(cond, bar) do { unsigned _sp = 0; while (cond) { __builtin_amdgcn_s_sleep(1); \
    if ((++_sp & 255u) == 0u) { if (xb_ld(&(bar)[XB_TMO])) break; if (_sp > XB_SPIN_CAP) { atomicAdd(&(bar)[XB_TMO], 1u); break; } } } } while (0)

struct XcdBarrier {
    unsigned* bar; unsigned x;
    volatile LAS unsigned* st;
};

__device__ __forceinline__ XcdBarrier xcd_barrier_post(unsigned* bar, volatile LAS unsigned* st) {
    XcdBarrier b; b.bar = bar; b.x = xb_xcc_id(); b.st = st;
    if (threadIdx.x == 0) (void)xb_add(&bar[XB_XCNT(b.x)], 1u);
    return b;
}
__device__ __forceinline__ void xcd_barrier_complete(unsigned* bar, unsigned x, unsigned& nloc, unsigned& nx) {
    const unsigned G = gridDim.x * gridDim.y * gridDim.z;
    unsigned sum, cnt, mine, sp = 0u;
    for (;;) {
        sum = 0u; cnt = 0u; mine = 0u;
#pragma unroll
        for (unsigned j = 0; j < 16; ++j) { const unsigned c = xb_ld(&bar[XB_XCNT(j)]); sum += c; cnt += (c > 0u) ? 1u : 0u; mine = (j == x) ? c : mine; }
        if (sum == G) break;
        __builtin_amdgcn_s_sleep(1);
        if ((++sp & 255u) == 0u) { if (xb_ld(&bar[XB_TMO])) break; if (sp > XB_SPIN_CAP) { atomicAdd(&bar[XB_TMO], 1u); break; } }
    }
    nloc = mine > 0u ? mine : 1u; nx = cnt > 0u ? cnt : 1u;
}

__device__ __forceinline__ void xcd_barrier(const XcdBarrier& b) {
    asm volatile("s_waitcnt vmcnt(0)" ::: "memory");
    __syncthreads();
    if (threadIdx.x == 0) {
        unsigned* bar = b.bar;
        __builtin_amdgcn_s_waitcnt(0);
        unsigned nloc = b.st[0], nx = b.st[1];
        if (nloc == 0u) { xcd_barrier_complete(bar, b.x, nloc, nx); b.st[0] = nloc; b.st[1] = nx; }
        const unsigned old = xb_add(&bar[XB_XSUB(b.x)], 1u);
        const unsigned gen = old / nloc;
        if (old + 1u == (gen + 1u) * nloc) {
            __builtin_amdgcn_fence(__ATOMIC_RELEASE, "agent");
            asm volatile("s_waitcnt vmcnt(0)" ::: "memory");
            const unsigned og = xb_add(&bar[XB_TOP], 1u);
            const unsigned tg = og / nx;
            if (og + 1u == (tg + 1u) * nx) xb_add(&bar[XB_TOPGEN], 1u);
            else XB_SPIN(xb_ld(&bar[XB_TOPGEN]) == tg, bar);
            __builtin_amdgcn_fence(__ATOMIC_ACQUIRE, "agent");
            xb_add(&bar[XB_XGEN(b.x)], 1u);
            asm volatile("s_waitcnt vmcnt(0)" ::: "memory");
        } else {
            XB_SPIN(xb_ld(&bar[XB_XGEN(b.x)]) == gen, bar);
            __builtin_amdgcn_fence(__ATOMIC_ACQUIRE, "agent");
            asm volatile("s_waitcnt vmcnt(0)" ::: "memory");
        }
    }
    __syncthreads();
}

namespace attn_body {
using bf16=_Float16;
using bf16x8=__attribute__((ext_vector_type(8)))_Float16;
using s16x4=__attribute__((ext_vector_type(4)))_Float16;
typedef float f32x4_t __attribute__((ext_vector_type(4)));
using f32x16=__attribute__((ext_vector_type(16)))float;
using u32x4=__attribute__((ext_vector_type(4)))unsigned;
constexpr int BATCH=8,NHEAD=8,SEQ=4096,D=64,DM=NHEAD*D,OPITCH=1024;
constexpr int NW=8,QBLK=32,QB=QBLK*NW,KVBLK=64,NQB=SEQ/QB;
constexpr int ATTN_PITCH=DM, ATTN_UNIT_ROWS=QB;
__device__ __forceinline__ int crow(int r,int hi){return (r&3)+8*(r>>2)+4*hi;}
#define SBAR() __builtin_amdgcn_sched_barrier(0)
__device__ __forceinline__ void cmask(f32x16&p0,f32x16&p1,int jb,int qrel,int hi){
  const float NEG=-INFINITY; int kb=64*jb+4*hi;
  #pragma unroll
  for(int r=0;r<16;++r){int kv=kb+(r&3)+8*(r>>2); if(kv>qrel)p0[r]=NEG; if(kv+32>qrel)p1[r]=NEG;}
}

constexpr int NSLOT=3, SLOTB=8192, LDS_MK=103424;
constexpr int LDS_K=0, LDS_V=NSLOT*SLOTB, LDS_WS=2*NSLOT*SLOTB, LDS_OST=LDS_WS+NW*64*4, LDS_BYTES=LDS_OST+NW*4096;
constexpr float C2=0.125f*1.4426950408889634f;
__device__ __forceinline__ void glds16(const void*gsrc,unsigned lds_dst){unsigned keep;
  asm volatile("s_mov_b32 %0, m0\n\ts_mov_b32 m0, %2\n\ts_nop 0\n\tglobal_load_lds_dwordx4 %1, off\n\ts_mov_b32 m0, %0":"=&s"(keep):"v"(gsrc),"s"(lds_dst):"memory");}
__device__ __forceinline__ void glds4(const void*gsrc,unsigned lds_dst){unsigned keep;
  asm volatile("s_mov_b32 %0, m0\n\ts_mov_b32 m0, %2\n\ts_nop 0\n\tglobal_load_lds_dword %1, off\n\ts_mov_b32 m0, %0":"=&s"(keep):"v"(gsrc),"s"(lds_dst):"memory");}
__device__ __forceinline__ float max3f(float a,float b,float c){float r;asm("v_max3_f32 %0, %1, %2, %3":"=v"(r):"v"(a),"v"(b),"v"(c));return r;}
__device__ __forceinline__ float max2f(float a,float b){float r;asm("v_max_f32_e32 %0, %1, %2":"=v"(r):"v"(a),"v"(b));return r;}
__device__ __forceinline__ float fadd_s(float a,float b){float r;asm("v_add_f32_e32 %0, %1, %2":"=v"(r):"v"(a),"v"(b));return r;}
__device__ __forceinline__ float fsub_s(float a,float b){float r;asm("v_sub_f32_e32 %0, %1, %2":"=v"(r):"v"(a),"v"(b));return r;}
typedef float f32x2_t __attribute__((ext_vector_type(2))); typedef _Float16 bf16x2_t __attribute__((ext_vector_type(2)));
__device__ __forceinline__ unsigned cvtpk_s(float lo,float hi){f32x2_t v={lo,hi};bf16x2_t b=__builtin_convertvector(v,bf16x2_t);return __builtin_bit_cast(unsigned,b);}
#define WAIT_BAR(N) asm volatile("s_waitcnt vmcnt(" #N ") lgkmcnt(0)\n\ts_barrier":::"memory")

__device__ __forceinline__ void qkt(f32x16&p0,f32x16&p1,const char*Kslot,const bf16x8*qr,const f32x16&negm,int r32,int hi){
  const char*kb=Kslot+hi*1024+r32*16;
  #pragma unroll
  for(int d0=0;d0<4;++d0){
    const bf16x8 b0=*reinterpret_cast<const bf16x8*>(kb+d0*2048);
    const bf16x8 b1=*reinterpret_cast<const bf16x8*>(kb+d0*2048+512);
    if(d0==0){p0=__builtin_amdgcn_mfma_f32_32x32x16_f16(b0,qr[0],negm,0,0,0);p1=__builtin_amdgcn_mfma_f32_32x32x16_f16(b1,qr[0],negm,0,0,0);}
    else{p0=__builtin_amdgcn_mfma_f32_32x32x16_f16(b0,qr[d0],p0,0,0,0);p1=__builtin_amdgcn_mfma_f32_32x32x16_f16(b1,qr[d0],p1,0,0,0);}}
}
typedef __attribute__((address_space(3))) const char* lds_cptr;
typedef short v4i16_t __attribute__((ext_vector_type(4)));
__device__ __forceinline__ void kload8(bf16x8*kf,lds_cptr kp){
  kf[0]=*(const __attribute__((address_space(3))) bf16x8*)(kp);      kf[1]=*(const __attribute__((address_space(3))) bf16x8*)(kp+512);
  kf[2]=*(const __attribute__((address_space(3))) bf16x8*)(kp+2048); kf[3]=*(const __attribute__((address_space(3))) bf16x8*)(kp+2560);
  kf[4]=*(const __attribute__((address_space(3))) bf16x8*)(kp+4096); kf[5]=*(const __attribute__((address_space(3))) bf16x8*)(kp+4608);
  kf[6]=*(const __attribute__((address_space(3))) bf16x8*)(kp+6144); kf[7]=*(const __attribute__((address_space(3))) bf16x8*)(kp+6656);
}
__device__ __forceinline__ void kload2(bf16x8*kf,lds_cptr kp,int j){ kf[2*j]=*(const __attribute__((address_space(3))) bf16x8*)(kp+j*2048); kf[2*j+1]=*(const __attribute__((address_space(3))) bf16x8*)(kp+j*2048+512); }
__device__ __forceinline__ s16x4 vtr(lds_cptr p){ return __builtin_bit_cast(s16x4,__builtin_amdgcn_ds_read_tr16_b64_v4i16((__attribute__((address_space(3))) v4i16_t*)p)); }
__device__ __forceinline__ float rowmax(const f32x16&p0,const f32x16&p1){
  float a=max3f(p0[0],p0[1],p1[0]),b=max3f(p0[2],p0[3],p1[1]);a=max3f(a,p1[2],p1[3]);
  #pragma unroll
  for(int r=4;r<16;r+=4){a=max3f(a,p0[r],p0[r+1]);b=max3f(b,p0[r+2],p0[r+3]);a=max3f(a,p1[r],p1[r+1]);b=max3f(b,p1[r+2],p1[r+3]);}
  const float m=max2f(a,b);
  auto rr=__builtin_amdgcn_permlane32_swap(__float_as_uint(m),__float_as_uint(m),false,false);
  return max2f(__uint_as_float(rr[0]),__uint_as_float(rr[1]));
}
__device__ __forceinline__ void pv(f32x16*o,int vb,bf16x8 pa0,bf16x8 pa1,bf16x8 pa2,bf16x8 pa3){
  #pragma unroll
  for(int d0=0;d0<2;++d0){s16x4 lo[4],hi[4];
    #pragma unroll
    for(int ks=0;ks<4;++ks){
      asm volatile("ds_read_b64_tr_b16 %0,%1 offset:%c2":"=&v"(lo[ks]):"v"(vb),"i"(d0*4096+ks*1024):"memory");
      asm volatile("ds_read_b64_tr_b16 %0,%1 offset:%c2":"=&v"(hi[ks]):"v"(vb),"i"(d0*4096+ks*1024+512):"memory");}
    asm volatile("s_waitcnt lgkmcnt(0)":::"memory");SBAR();
    #define PK(k) (bf16x8){lo[k][0],lo[k][1],lo[k][2],lo[k][3],hi[k][0],hi[k][1],hi[k][2],hi[k][3]}
    o[d0]=__builtin_amdgcn_mfma_f32_32x32x16_f16(pa0,PK(0),o[d0],0,0,0);
    o[d0]=__builtin_amdgcn_mfma_f32_32x32x16_f16(pa1,PK(1),o[d0],0,0,0);
    o[d0]=__builtin_amdgcn_mfma_f32_32x32x16_f16(pa2,PK(2),o[d0],0,0,0);
    o[d0]=__builtin_amdgcn_mfma_f32_32x32x16_f16(pa3,PK(3),o[d0],0,0,0);
    #undef PK
  }
}

#ifndef ATTN_STORE16
#define ATTN_STORE16(p,v) (*(u32x4*)(p)=(v))
#endif
typedef const __attribute__((address_space(3))) float* lds_cfptr;
template<int THRL,int MODE> __device__ __forceinline__ void attn_unit(int b,int h,int qb,const bf16*Q,const bf16*__restrict__ K,const bf16*__restrict__ V,bf16*O,float*ssq,int grp,lds_cfptr biasL,const unsigned*maskp,char*shm){
  int tid_=threadIdx.x; asm volatile("":"+v"(tid_));
  const int tid=tid_,lane=tid&63,r32=lane&31,hi=lane>>5; const int wid=__builtin_amdgcn_readfirstlane(tid>>6);
  const long rowbase=(long)b*SEQ; const int q0=qb*QB;
  const bf16*Qw=Q+(rowbase+q0+wid*QBLK)*DM+h*D;
  const bf16*Kh=K+rowbase*DM+h*D,*Vh=V+rowbase*DM+h*D;
  const unsigned lds0=(unsigned)(uintptr_t)shm;
  float*wsf=(float*)(shm+LDS_WS)+wid*64;
  const bf16*ksrc=Kh+(long)lane*DM+wid*8;
  const bf16*vsrc=Vh+(long)(16*(wid&3)+(lane>>2))*DM+(wid>>2)*32+(lane&3)*8;
  const unsigned kdst=lds0+LDS_K+wid*1024, vdst=lds0+LDS_V+wid*1024;
  #define DMA_K(t,slot) glds16(ksrc+(long)(t)*KVBLK*DM,(unsigned)__builtin_amdgcn_readfirstlane(kdst+(slot)))
  #define DMA_V(t,slot) glds16(vsrc+(long)(t)*KVBLK*DM,(unsigned)__builtin_amdgcn_readfirstlane(vdst+(slot)))
  const int vb0=(int)(lds0+LDS_V)+((lane>>4)&1)*32+(lane&3)*8+(4*hi+((lane&15)>>2))*64;
  const char*Kbase=shm+LDS_K; bf16x8 kf[8];
  const lds_cptr shm3=(lds_cptr)shm; const lds_cptr kp0=shm3+LDS_K+hi*1024+r32*16; const lds_cptr vp0=shm3+LDS_V+((lane>>4)&1)*32+(lane&3)*8+(4*hi+((lane&15)>>2))*64;
  const int NT=(q0+QB)/KVBLK;
  const int qrel=wid*QBLK+r32;
  unsigned mkA=0xffffffffu,mkB=0xffffffffu; const unsigned*mk_src=maskp+(rowbase+q0+qrel)*128+hi;
  const unsigned mk_lds=lds0+LDS_MK+wid*512; const __attribute__((address_space(3))) unsigned* mk_rd=(const __attribute__((address_space(3))) unsigned*)(shm3+LDS_MK+wid*512)+lane;
  #define MLOAD(t) do{ if(MODE==1){ glds4(mk_src+2*(t),(unsigned)__builtin_amdgcn_readfirstlane(mk_lds+(((t)&1)*256))); } }while(0)
  #define MREAD(MK,sl) do{ if(MODE==1){ MK=mk_rd[(sl)*64]; } }while(0)
  MLOAD(0); MLOAD(1);
  float bq=0.f; if(MODE==0) bq=biasL[q0+qrel];
  DMA_K(0,0);DMA_V(0,0);DMA_K(1,SLOTB);
  bf16x8 qr[4];
  #pragma unroll
  for(int d0=0;d0<4;++d0)qr[d0]=*reinterpret_cast<const bf16x8*>(&Qw[(long)r32*DM+d0*16+hi*8]);
  float zf_; asm volatile("v_mov_b32 %0, 0":"=v"(zf_));
  float mhat=0.f,l_reg=0.f;f32x16 o[2];f32x16 negm;
  #pragma unroll
  for(int r=0;r<16;++r){o[0][r]=zf_;o[1][r]=zf_;negm[r]=zf_;}
  asm volatile("":"+v"(negm));
  #define CMASK(P0,P1,t) do{int jb_=(t)-(NT-4); if(jb_>=0)cmask(P0,P1,jb_,qrel,hi);}while(0)
  #define BIAS(P0,P1,t) do{ if(MODE==0){ const lds_cfptr bp_=biasL+(t)*64+4*hi; \
      _Pragma("unroll") for(int g_=0;g_<4;++g_){ const f32x4_t b0_=*(const __attribute__((address_space(3))) f32x4_t*)(bp_+8*g_), b1_=*(const __attribute__((address_space(3))) f32x4_t*)(bp_+32+8*g_); \
        _Pragma("unroll") for(int e_=0;e_<4;++e_){ P0[4*g_+e_]+=b0_[e_]; P1[4*g_+e_]+=b1_[e_]; } } } }while(0)
  #define MASKX(X,B,SH,MK) do{ if(MODE==1){ _Pragma("unroll") for(int i_=0;i_<4;++i_) X[(B)+i_]=__uint_as_float(__float_as_uint(X[(B)+i_])&(unsigned)__builtin_amdgcn_sbfe((int)(MK),(SH)+(B)+i_,1)); } }while(0)
  bool resc=false;
  #define START(P0,P1) do{ const float rm=(MODE==0)?bq:rowmax(P0,P1); resc=false; \
    { const float dl=rm; mhat=fadd_s(mhat,dl); \
      _Pragma("unroll") for(int r=0;r<16;++r){P0[r]=fsub_s(P0[r],dl);P1[r]=fsub_s(P1[r],dl);} \
      _Pragma("unroll") for(int r=0;r<16;++r)negm[r]=-mhat; asm volatile("":"+v"(negm)); } \
    _Pragma("unroll") for(int r=0;r<16;++r)P0[r]=__builtin_amdgcn_exp2f(P0[r]); \
    MASKX(P0,0,0,mkA);MASKX(P0,4,0,mkA);MASKX(P0,8,0,mkA);MASKX(P0,12,0,mkA); }while(0)
  #define RESC() do{ if(resc){ asm volatile("s_waitcnt lgkmcnt(0)":::"memory"); \
      _Pragma("unroll") for(int d_=0;d_<2;++d_) _Pragma("unroll") for(int r=0;r<16;++r)o[d_][r]*=wsf[crow(r,hi)]; } }while(0)
  f32x16 pA0,pA1,pB0,pB1;
  int sl_prev=0,sl_cur=0,sl_next=SLOTB;
  #define ROT() do{sl_prev=sl_cur;sl_cur=sl_next;sl_next=(sl_next==(NSLOT-1)*SLOTB)?0:sl_next+SLOTB;}while(0)
  DMA_K(2,2*SLOTB);
  WAIT_BAR(3); MREAD(mkA,0); MREAD(mkB,1);
  qkt(pA0,pA1,Kbase,qr,negm,r32,hi);asm volatile("s_nop 15\n\ts_nop 7":"+v"(pA0),"+v"(pA1));BIAS(pA0,pA1,0);CMASK(pA0,pA1,0);
  START(pA0,pA1);
  _Pragma("unroll") for(int r=0;r<16;++r)pA1[r]=__builtin_amdgcn_exp2f(pA1[r]);
  MASKX(pA1,0,16,mkA);MASKX(pA1,4,16,mkA);MASKX(pA1,8,16,mkA);MASKX(pA1,12,16,mkA);
  WAIT_BAR(0);
  DMA_K(3,0);DMA_V(1,SLOTB);
  ROT();
  kload8(kf,kp0+sl_cur);
  WAIT_BAR(2);
  s16x4 vlo[8],vhi[8]; u32x4 pw0,pw1,pw2,pw3;
  #define PKW(P,B) cvtpk_s(P[B],P[B+1])
  #define PAF(k) __builtin_bit_cast(bf16x8,pw##k)
  #define VFR(i) (bf16x8){vlo[i][0],vlo[i][1],vlo[i][2],vlo[i][3],vhi[i][0],vhi[i][1],vhi[i][2],vhi[i][3]}
  #define PIN(x) asm volatile("":"+v"(x))
  #define MX3(a,b,c) __builtin_fmaxf(__builtin_fmaxf((a),(b)),(c))
  #define GAPA(MF,A0,A1,A2,A3,W0,W1,PW) do{ MF; sacc+=A0; sacc+=A1; sacc+=A2; sacc+=A3; PIN(sacc); W0; W1; PIN(PW); SBAR(); }while(0)
  #define EX(v) __builtin_amdgcn_exp2f(v)
  #define GAPB(MF,X,B,SH) do{ MF; X[B]=EX(X[B]); X[B+1]=EX(X[B+1]); X[B+2]=EX(X[B+2]); X[B+3]=EX(X[B+3]); MASKX(X,B,SH,MKC_); PIN(X); SBAR(); }while(0)
  #define VRD(i) do{ vlo[i]=vtr(vp_+(((i)>>2)*4096+((i)&3)*1024)); vhi[i]=vtr(vp_+(((i)>>2)*4096+((i)&3)*1024+512)); }while(0)
  #define KRD(G,j) do{ if(G){ kload2(kf,kp0+sl_next,j); SBAR(); } }while(0)
  #define STEP(C0,C1,P0,P1,t,GK,GV,GL,MKC) do{ SBAR(); \
    const unsigned MKC_=(MKC); \
    const lds_cptr vp_=vp0+sl_prev; \
    VRD(0); SBAR(); float sacc=(P0[0]+P0[1]); \
    GAPA(C0=__builtin_amdgcn_mfma_f32_32x32x16_f16(kf[0],qr[0],negm,0,0,0), P0[2],P0[3],P0[4],P0[5],     pw0[0]=PKW(P0,0), pw0[1]=PKW(P0,2), pw0); \
    VRD(4); SBAR(); GAPA(C1=__builtin_amdgcn_mfma_f32_32x32x16_f16(kf[1],qr[0],negm,0,0,0), P0[6],P0[7],P0[8],P0[9],     pw0[2]=PKW(P0,4), pw0[3]=PKW(P0,6), pw0); \
    VRD(1); SBAR(); GAPA(C0=__builtin_amdgcn_mfma_f32_32x32x16_f16(kf[2],qr[1],C0,0,0,0),   P0[10],P0[11],P0[12],P0[13], pw1[0]=PKW(P0,8), pw1[1]=PKW(P0,10), pw1); \
    VRD(5); SBAR(); GAPA(C1=__builtin_amdgcn_mfma_f32_32x32x16_f16(kf[3],qr[1],C1,0,0,0),   P0[14],P0[15],P1[0],P1[1],   pw1[2]=PKW(P0,12),pw1[3]=PKW(P0,14), pw1); \
    VRD(2); SBAR(); GAPA(C0=__builtin_amdgcn_mfma_f32_32x32x16_f16(kf[4],qr[2],C0,0,0,0),   P1[2],P1[3],P1[4],P1[5],     pw2[0]=PKW(P1,0), pw2[1]=PKW(P1,2), pw2); \
    VRD(6); SBAR(); GAPA(C1=__builtin_amdgcn_mfma_f32_32x32x16_f16(kf[5],qr[2],C1,0,0,0),   P1[6],P1[7],P1[8],P1[9],     pw2[2]=PKW(P1,4), pw2[3]=PKW(P1,6), pw2); \
    VRD(3); SBAR(); GAPA(C0=__builtin_amdgcn_mfma_f32_32x32x16_f16(kf[6],qr[3],C0,0,0,0),   P1[10],P1[11],P1[12],P1[13], pw3[0]=PKW(P1,8), pw3[1]=PKW(P1,10), pw3); \
    VRD(7); SBAR(); GAPA(C1=__builtin_amdgcn_mfma_f32_32x32x16_f16(kf[7],qr[3],C1,0,0,0),   P1[14],P1[15],0.f,0.f,       pw3[2]=PKW(P1,12),pw3[3]=PKW(P1,14), pw3); \
    l_reg+=sacc; \
    if(GV){MLOAD((t)+1);} if(GK){DMA_K((t)+3,sl_cur);} if(GV){DMA_V((t)+1,sl_next);} \
    BIAS(C0,C1,t); CMASK(C0,C1,t); \
    { float a=MX3(C0[0],C0[1],C1[0]),b=MX3(C0[2],C0[3],C1[1]); a=MX3(a,C1[2],C1[3]); \
      _Pragma("unroll") for(int r=4;r<16;r+=4){a=MX3(a,C0[r],C0[r+1]);b=MX3(b,C0[r+2],C0[r+3]);a=MX3(a,C1[r],C1[r+1]);b=MX3(b,C1[r+2],C1[r+3]);} \
      float rm=__builtin_fmaxf(a,b); { auto rr=__builtin_amdgcn_permlane32_swap(__float_as_uint(rm),__float_as_uint(rm),false,false); rm=__builtin_fmaxf(__uint_as_float(rr[0]),__uint_as_float(rr[1])); } \
      resc=false; \
      if(__builtin_expect(__any(rm>(float)THRL),0)){ const float dl=__builtin_fmaxf(rm,0.f); mhat+=dl; \
        _Pragma("unroll") for(int r=0;r<16;++r){C0[r]-=dl;C1[r]-=dl;} \
        _Pragma("unroll") for(int r=0;r<16;++r)negm[r]=-mhat; asm volatile("":"+v"(negm)); \
        const float f=__builtin_amdgcn_exp2f(-dl); l_reg*=f; if(hi==0)wsf[r32]=f; resc=true; } } \
    SBAR(); \
    GAPB(o[0]=__builtin_amdgcn_mfma_f32_32x32x16_f16(PAF(0),VFR(0),o[0],0,0,0), C0,0,0); \
    GAPB(o[1]=__builtin_amdgcn_mfma_f32_32x32x16_f16(PAF(0),VFR(4),o[1],0,0,0), C0,4,0); \
    KRD(GL,0); GAPB(o[0]=__builtin_amdgcn_mfma_f32_32x32x16_f16(PAF(1),VFR(1),o[0],0,0,0), C0,8,0); \
    KRD(GL,1); GAPB(o[1]=__builtin_amdgcn_mfma_f32_32x32x16_f16(PAF(1),VFR(5),o[1],0,0,0), C0,12,0); \
    KRD(GL,2); GAPB(o[0]=__builtin_amdgcn_mfma_f32_32x32x16_f16(PAF(2),VFR(2),o[0],0,0,0), C1,0,16); \
    KRD(GL,3); GAPB(o[1]=__builtin_amdgcn_mfma_f32_32x32x16_f16(PAF(2),VFR(6),o[1],0,0,0), C1,4,16); \
    GAPB(o[0]=__builtin_amdgcn_mfma_f32_32x32x16_f16(PAF(3),VFR(3),o[0],0,0,0), C1,8,16); \
    GAPB(o[1]=__builtin_amdgcn_mfma_f32_32x32x16_f16(PAF(3),VFR(7),o[1],0,0,0), C1,12,16); \
    }while(0)
  int t=1;
  #undef CMASK
  #define CMASK(P0,P1,t) do{}while(0)
  for(;t+5<NT;t+=2){
    STEP(pB0,pB1,pA0,pA1,t,true,true,true,mkB);     WAIT_BAR(2); MREAD(mkA,0); RESC(); ROT();
    STEP(pA0,pA1,pB0,pB1,t+1,true,true,true,mkA);   WAIT_BAR(2); MREAD(mkB,1); RESC(); ROT();
  }
  #undef CMASK
  #define CMASK(P0,P1,t) do{int jb_=(t)-(NT-4); if(jb_>=0)cmask(P0,P1,jb_,qrel,hi);}while(0)
  #define ENDW(tt) do{ if((tt)+3<NT){WAIT_BAR(2);} else if((tt)+2<NT){WAIT_BAR(1);} else {WAIT_BAR(0);} }while(0)
  for(;t+1<NT;t+=2){
    STEP(pB0,pB1,pA0,pA1,t,(t+3<NT),(t+1<NT),(t+1<NT),mkB);       ENDW(t);   MREAD(mkA,0); RESC(); ROT();
    STEP(pA0,pA1,pB0,pB1,t+1,(t+4<NT),(t+2<NT),(t+2<NT),mkA);     ENDW(t+1); MREAD(mkB,1); RESC(); ROT();
  }
  STEP(pB0,pB1,pA0,pA1,NT-1,false,false,false,mkB); RESC();
  { float sacc=pB0[0]+pB0[1]; _Pragma("unroll") for(int r=2;r<16;++r)sacc+=pB0[r]; _Pragma("unroll") for(int r=0;r<16;++r)sacc+=pB1[r]; l_reg+=sacc;
    pw0=(u32x4){PKW(pB0,0),PKW(pB0,2),PKW(pB0,4),PKW(pB0,6)};pw1=(u32x4){PKW(pB0,8),PKW(pB0,10),PKW(pB0,12),PKW(pB0,14)};pw2=(u32x4){PKW(pB1,0),PKW(pB1,2),PKW(pB1,4),PKW(pB1,6)};pw3=(u32x4){PKW(pB1,8),PKW(pB1,10),PKW(pB1,12),PKW(pB1,14)};
    SBAR(); pv(o,vb0+sl_cur,PAF(0),PAF(1),PAF(2),PAF(3)); }
  #undef PKW
  #undef PAF
  #undef VFR
  #undef PIN
  #undef MX3
  #undef GAPA
  #undef GAPB
  #undef EX
  #undef VRD
  #undef KRD
  #undef STEP
  #undef ENDW
  {auto rr=__builtin_amdgcn_permlane32_swap(__float_as_uint(l_reg),__float_as_uint(l_reg),false,false);l_reg=__uint_as_float(rr[0])+__uint_as_float(rr[1]);}
  if(hi==0)wsf[32+r32]=l_reg;asm volatile("s_waitcnt lgkmcnt(0)":::"memory");
  float rli[16];
  #pragma unroll
  for(int r=0;r<16;++r)rli[r]=__builtin_amdgcn_rcpf(wsf[32+crow(r,hi)]);
  bf16*Ow=O+(rowbase+q0+wid*QBLK)*OPITCH+grp*512+h*D; float*sq=ssq+(size_t)(grp*8+h)*((size_t)BATCH*SEQ)+(rowbase+q0+wid*QBLK);
  { bf16*stg=(bf16*)(shm+LDS_OST)+wid*2048;
    #pragma unroll
    for(int r=0;r<16;++r){const int orow=crow(r,hi);
      #pragma unroll
      for(int d0=0;d0<2;++d0)stg[orow*64+d0*32+r32]=(bf16)(o[d0][r]*rli[r]);}
    asm volatile("s_waitcnt lgkmcnt(0)":::"memory");
    #pragma unroll
    for(int i=0;i<4;++i){const int row=i*8+(lane>>3),ch=lane&7; const u32x4 v=*(const u32x4*)(stg+row*64+ch*8); ATTN_STORE16(Ow+(long)row*OPITCH+ch*8,v);
      float s2=0.f;
      #pragma unroll
      for(int e=0;e<4;++e){const unsigned we=v[e]; const bf16x2_t hv=__builtin_bit_cast(bf16x2_t,we); const float a0=(float)hv[0],a1=(float)hv[1]; s2+=a0*a0+a1*a1;}
      s2+=__shfl_xor(s2,1); s2+=__shfl_xor(s2,2); s2+=__shfl_xor(s2,4);
      if(ch==0)sq[row]=s2; } }
  asm volatile("s_waitcnt lgkmcnt(0)\n\ts_barrier":::"memory");
  #undef DMA_K
  #undef DMA_V
  #undef CMASK
  #undef START
  #undef RESC
  #undef ROT
}
constexpr int ATTN_LDS_BYTES=LDS_BYTES;
#undef SBAR
#undef WAIT_BAR
}
namespace sel {
constexpr int NTHR = 512;
typedef _Float16 h8 __attribute__((ext_vector_type(8)));
typedef float f32x16 __attribute__((ext_vector_type(16)));
constexpr int NB = 512, HSTR = 513, CAP = 256, NSLOT3 = 3;
constexpr int L_HIST = 0, L_CAND = 0, L_KEY = 0, R_HIST = 49152, R_CNT = 50176, R_SEL = 52224, R_MISC = 56320;
constexpr int L_MASK = 65792, L_MASKE = L_MASK + 16384, L_T0 = L_MASKE + 16384, L_KK = L_T0 + 128, L_CNT = L_KK + 128, L_FLAG = L_CNT + 128, L_EQF = L_FLAG + 128, L_SLOT = L_EQF + 128, L_CJ = L_SLOT + 128, L_WH = L_CJ + 2048, L_WQ = L_WH + 8192, L_END = L_WQ + 128;
static_assert(32 * HSTR * 4 <= L_MASK && 32 * CAP * 8 <= L_MASK && R_MISC + 256 <= L_MASK && L_END <= 131072, "select LDS map");
__device__ __forceinline__ int crow(int r, int hi) { return (r & 3) + 8 * (r >> 2) + 4 * hi; }
__device__ __forceinline__ int bucket_of(float sc, float cq) { const float f = __builtin_fmaf(sc, cq, 256.0f); return (int)__builtin_amdgcn_fmed3f(f, 0.0f, 511.0f); }
__device__ __forceinline__ unsigned mono_key32(float f) { const unsigned u = __float_as_uint(f); return (u & 0x80000000u) ? ~u : (u | 0x80000000u); }
__device__ __forceinline__ void idx_to_hwbit(int s, int& hw, int& bit) { const int jt = s >> 5, w = s & 31, h2 = (w >> 2) & 1; bit = (w & 3) | ((w >> 3) << 2); hw = (((jt >> 1) * 2 + h2) * 2 + (jt & 1)); }

__device__ __forceinline__ void radix_row(LAS unsigned* key, int n, LAS unsigned char* rs, LAS unsigned short* mrow, int tid) {
    LAS unsigned* hist = (LAS unsigned*)(rs + R_HIST); LAS unsigned* cnt = (LAS unsigned*)(rs + R_CNT); LAS unsigned char* selb = (LAS unsigned char*)(rs + R_SEL); LAS int* misc = (LAS int*)(rs + R_MISC);
    unsigned prefix = 0u, pmask = 0u; int kk = 256;
    for (int shift = 24; shift >= 0; shift -= 8) {
        __syncthreads();
        if (tid < 256) hist[tid] = 0u;
        __syncthreads();
        for (int s = tid; s < n; s += NTHR) { const unsigned k = key[s]; if ((k & pmask) == prefix) __hip_atomic_fetch_add(&hist[(k >> shift) & 255u], 1u, __ATOMIC_RELAXED, __HIP_MEMORY_SCOPE_WORKGROUP); }
        __syncthreads();
        if (tid < 256) { unsigned above = 0u; for (int b2 = tid + 1; b2 < 256; ++b2) above += hist[b2]; const unsigned mine = hist[tid];
            if ((int)above < kk && (int)(above + mine) >= kk) { misc[0] = tid; misc[1] = kk - (int)above; } }
        __syncthreads();
        prefix |= (unsigned)misc[0] << shift; pmask |= 255u << shift; kk = misc[1];
    }
    unsigned ceq = 0u;
    for (int i = 0; i < 8; ++i) { const int s = tid * 8 + i; if (s < n && key[s] == prefix) ++ceq; }
    cnt[tid] = ceq; __syncthreads();
    unsigned before = 0u; for (int j = 0; j < tid; ++j) before += cnt[j];
    for (int i = 0; i < 8; ++i) { const int s = tid * 8 + i; unsigned char v = 0; if (s < n) { const unsigned k = key[s];
        if (k > prefix) v = 1; else if (k == prefix) { if ((int)before < kk) v = 1; ++before; } } selb[s] = v; }
    __syncthreads();
    if (tid < 256) { const int hw = tid, J = hw >> 2, hi = (hw >> 1) & 1, j = 2 * J + (hw & 1); unsigned bits = 0u;
        for (int r = 0; r < 16; ++r) { if (selb[32 * j + crow(r, hi)]) bits |= 1u << r; }
        mrow[hw] = (unsigned short)bits; }
    __syncthreads();
}

template <int PASS> __device__ __forceinline__ void score_pass(const f16* ikb, int b, int qt, int wave, int lane, const h8 (&bq)[4][4], float w0, float w1, float w2, float w3, float cq,
                                                               LAS unsigned* r0, LAS unsigned short* maskL, LAS unsigned short* maskE, LAS unsigned* ccnt, LAS unsigned* eqf, int T0, int slot) {
    const int ql = lane & 31, hi = lane >> 5;
    const f16* kbase = ikb + ((size_t)b * S_ + ql) * 64 + 8 * hi;
    h8 a[4], an[4];
#pragma unroll
    for (int ks = 0; ks < 4; ++ks) a[ks] = *(const h8*)(kbase + (size_t)(32 * wave) * 64 + 16 * ks);
    for (int kt = wave; kt <= qt; kt += 8) {
        const bool more = (kt + 8 <= qt);
        if (more) {
#pragma unroll
            for (int ks = 0; ks < 4; ++ks) an[ks] = *(const h8*)(kbase + (size_t)(32 * (kt + 8)) * 64 + 16 * ks); }
        f32x16 acc[4];
#pragma unroll
        for (int h = 0; h < 4; ++h) { acc[h] = __builtin_amdgcn_mfma_f32_32x32x16_f16(a[0], bq[h][0], (f32x16){0.f}, 0, 0, 0);
#pragma unroll
            for (int ks = 1; ks < 4; ++ks) acc[h] = __builtin_amdgcn_mfma_f32_32x32x16_f16(a[ks], bq[h][ks], acc[h], 0, 0, 0); }
        const bool diag = (kt == qt);
        unsigned bits = 0u, ebits = 0u;
#pragma unroll
        for (int r = 0; r < 16; ++r) {
            float sc = fmaxf(acc[0][r], 0.f) * w0; sc = __builtin_fmaf(fmaxf(acc[1][r], 0.f), w1, sc); sc = __builtin_fmaf(fmaxf(acc[2][r], 0.f), w2, sc); sc = __builtin_fmaf(fmaxf(acc[3][r], 0.f), w3, sc);
            const bool valid = !diag || (crow(r, hi) <= ql);
            if (PASS == 3) { if (slot >= 0) r0[slot * 4096 + 32 * kt + crow(r, hi)] = valid ? mono_key32(sc) : 0u; }
            else {
                const int bk = bucket_of(sc, cq);
                if (PASS == 1) { if (valid) __hip_atomic_fetch_add(r0 + ql * HSTR + bk, 1u, __ATOMIC_RELAXED, __HIP_MEMORY_SCOPE_WORKGROUP); }
                else {
                    if (valid && bk > T0) bits |= 1u << r;
                    if (valid && bk == T0) { if (sc == 0.0f) ebits |= 1u << r; else { const unsigned sl = __hip_atomic_fetch_add(ccnt + ql, 1u, __ATOMIC_RELAXED, __HIP_MEMORY_SCOPE_WORKGROUP);
                        if (sl < (unsigned)CAP) { r0[(ql * CAP + sl) * 2] = mono_key32(sc); r0[(ql * CAP + sl) * 2 + 1] = (unsigned)(32 * kt + crow(r, hi)); } } }
                }
            }
        }
        if (PASS == 2) { const int hwi = ql * 256 + (((kt >> 1) * 2 + hi) * 2 + (kt & 1)); maskL[hwi] = (unsigned short)bits; if (ebits) { maskE[hwi] = (unsigned short)ebits; eqf[ql] = 1u; } }
        if (more) {
#pragma unroll
            for (int ks = 0; ks < 4; ++ks) a[ks] = an[ks]; }
    }
}

__device__ __forceinline__ void select_unit(const f16* iqb, const f16* ikb, const float* iwb, unsigned short* mask, int b, int qt, LAS unsigned char* lds, int wave, LAS unsigned* tsl) {
#ifdef TPROBE
#define STS0(v) unsigned long long v = __builtin_amdgcn_s_memrealtime()
#define STS1(slot, v) do { if (threadIdx.x == 0) tsl[slot] += (unsigned)(__builtin_amdgcn_s_memrealtime() - (v)); } while (0)
#else
#define STS0(v) do {} while (0)
#define STS1(slot, v) do {} while (0)
#endif
    (void)tsl;
    int tid = threadIdx.x; asm volatile("" : "+v"(tid)); const int lane = tid & 63;
    const int t0 = 32 * qt;
    LAS unsigned* r0 = (LAS unsigned*)(lds + L_HIST); LAS unsigned short* maskL = (LAS unsigned short*)(lds + L_MASK); LAS unsigned short* maskE = (LAS unsigned short*)(lds + L_MASKE);
    LAS int* T0s = (LAS int*)(lds + L_T0); LAS int* KKs = (LAS int*)(lds + L_KK); LAS unsigned* ccnt = (LAS unsigned*)(lds + L_CNT); LAS unsigned* flag = (LAS unsigned*)(lds + L_FLAG);
    LAS unsigned* eqf = (LAS unsigned*)(lds + L_EQF); LAS int* slotm = (LAS int*)(lds + L_SLOT); LAS unsigned* wq = (LAS unsigned*)(lds + L_WQ); LAS unsigned* cj = (LAS unsigned*)(lds + L_CJ);
    __syncthreads();
    if (qt < 8) {
        for (int e = tid; e < 32 * 256; e += NTHR) { const int q = e >> 8, hw = e & 255, J = hw >> 2, hi = (hw >> 1) & 1, j = 2 * J + (hw & 1), t = t0 + q; unsigned bits = 0u;
#pragma unroll
            for (int r = 0; r < 16; ++r) if (32 * j + crow(r, hi) <= t) bits |= 1u << r;
            maskL[e] = (unsigned short)bits; }
    } else {
        for (int e = tid; e < 32 * HSTR; e += NTHR) r0[e] = 0u;
        for (int e = tid; e < 2 * 32 * 128; e += NTHR) ((LAS unsigned*)maskL)[e] = 0u;
        if (tid < 32) { ccnt[tid] = 0u; flag[tid] = 0u; eqf[tid] = 0u; } if (tid == 0) *wq = 0u;
        const int ql = lane & 31, hi = lane >> 5; const size_t qrow = (size_t)b * S_ + t0 + ql;
        h8 bq[4][4];
#pragma unroll
        for (int h = 0; h < 4; ++h)
#pragma unroll
            for (int ks = 0; ks < 4; ++ks) bq[h][ks] = *(const h8*)(iqb + qrow * 256 + h * 64 + 16 * ks + 8 * hi);
        const f32x4 wv = *(const f32x4*)(iwb + qrow * 4); const float w0 = wv.x * 0.125f, w1 = wv.y * 0.125f, w2 = wv.z * 0.125f, w3 = wv.w * 0.125f;
        const float cq = 65.0f / fmaxf(sqrtf((wv.x * wv.x + wv.y * wv.y) + (wv.z * wv.z + wv.w * wv.w)), 1e-30f);
        __syncthreads();
        STS0(s1_);
        score_pass<1>(ikb, b, qt, wave, lane, bq, w0, w1, w2, w3, cq, r0, maskL, maskE, ccnt, eqf, 0, -1);
        __syncthreads();
        STS1(16, s1_); STS0(s2_);
        { const int q = tid >> 4, j = tid & 15; unsigned c = 0u;
          for (int i = 0; i < 32; ++i) c += r0[q * HSTR + 32 * j + ((i + 2 * j) & 31)];
          cj[q * 16 + j] = c; }
        __syncthreads();
        { const int q = tid >> 4, j = tid & 15; unsigned above = 0u; for (int j2 = j + 1; j2 < 16; ++j2) above += cj[q * 16 + j2];
          const unsigned mine = cj[q * 16 + j];
          if (above < 256u && above + mine >= 256u) { int bk = 32 * j + 31; unsigned run = above;
              for (;; --bk) { const unsigned hc = r0[q * HSTR + bk]; if (run + hc >= 256u) break; run += hc; }
              T0s[q] = bk; KKs[q] = (int)(256u - run); } }
        __syncthreads();
        const int T0 = T0s[ql];
        STS1(17, s2_); STS0(s3_);
        score_pass<2>(ikb, b, qt, wave, lane, bq, w0, w1, w2, w3, cq, r0, maskL, maskE, ccnt, eqf, T0, -1);
        __syncthreads();
        STS1(18, s3_); STS0(s4_);
        LAS unsigned* wsc = cj + wave * 64;
        for (int it = 0; it < 32; ++it) { int q = 0; if (lane == 0) q = (int)__hip_atomic_fetch_add(wq, 1u, __ATOMIC_RELAXED, __HIP_MEMORY_SCOPE_WORKGROUP); q = __builtin_amdgcn_readfirstlane(q); if (q >= 32) break;
            const unsigned nc = ccnt[q]; const int kk = KKs[q];
            if (nc > (unsigned)CAP) { if (lane == 0) flag[q] = 1u; continue; }
            const bool haseq = eqf[q] != 0u;
            unsigned nz = 0u, before = 0u, wA = 0u, wB = 0u, cA = 0u, cB = 0u;
            if (haseq) {
                const unsigned e0 = ((LAS unsigned*)maskE)[q * 128 + 2 * lane], e1 = ((LAS unsigned*)maskE)[q * 128 + 2 * lane + 1];
#pragma unroll
                for (int g = 0; g < 4; ++g) { wA |= (((e0 >> (4 * g)) & 0xFu) << (8 * g)) | (((e1 >> (4 * g)) & 0xFu) << (8 * g + 4));
                                              wB |= (((e0 >> (16 + 4 * g)) & 0xFu) << (8 * g)) | (((e1 >> (16 + 4 * g)) & 0xFu) << (8 * g + 4)); }
                cA = __builtin_popcount(wA); cB = __builtin_popcount(wB);
                wsc[lane] = cA + cB;
                _Pragma("unroll 1") for (int l2 = 0; l2 < 64; ++l2) nz += wsc[l2];
                _Pragma("unroll 1") for (int l2 = 0; l2 < lane; ++l2) before += wsc[l2];
            }
            unsigned npos = 0u;
            for (unsigned c0 = 0; c0 < nc; c0 += 64) { const unsigned ci = c0 + lane; const bool pos = (ci < nc) && (r0[(q * CAP + ci) * 2] > 0x80000000u); npos += __builtin_popcountll(__ballot(pos)); }
            const int m = (kk <= (int)npos) ? kk : (((int)npos > kk - (int)nz) ? (int)npos : kk - (int)nz);
            if (nc <= 64u) {
                const bool have = (unsigned)lane < nc; unsigned myk = 0u, myi = 0u; if (have) { myk = r0[(q * CAP + lane) * 2]; myi = r0[(q * CAP + lane) * 2 + 1]; }
                unsigned rank = 0u;
                for (unsigned j = 0; j < nc; ++j) { const unsigned kj = r0[(q * CAP + j) * 2], ij = r0[(q * CAP + j) * 2 + 1]; rank += (kj > myk || (kj == myk && ij < myi)) ? 1u : 0u; }
                if (have && (int)rank < m) { int hw, bit; idx_to_hwbit((int)myi, hw, bit);
                    __hip_atomic_fetch_or((LAS unsigned*)maskL + q * 128 + (hw >> 1), 1u << (bit + 16 * (hw & 1)), __ATOMIC_RELAXED, __HIP_MEMORY_SCOPE_WORKGROUP); }
            } else if (m > 0) {
                LAS unsigned* wh = (LAS unsigned*)(lds + L_WH) + wave * 256;
                unsigned prefix = 0u, pmask = 0u; int mm = m;
                for (int shift = 24; shift >= 0; shift -= 8) {
#pragma unroll
                    for (int e = 0; e < 4; ++e) wh[lane + 64 * e] = 0u;
                    for (unsigned ci = lane; ci < nc; ci += 64) { const unsigned k = r0[(q * CAP + ci) * 2]; if ((k & pmask) == prefix) __hip_atomic_fetch_add(&wh[(k >> shift) & 255u], 1u, __ATOMIC_RELAXED, __HIP_MEMORY_SCOPE_WORKGROUP); }
                    const unsigned h0 = wh[4 * lane], h1 = wh[4 * lane + 1], h2 = wh[4 * lane + 2], h3 = wh[4 * lane + 3];
                    wsc[lane] = h0 + h1 + h2 + h3;
                    unsigned above = 0u; _Pragma("unroll 1") for (int l2 = lane + 1; l2 < 64; ++l2) above += wsc[l2];
                    int fb = -1, fm = 0;
                    { unsigned run = above; if ((int)run < mm && (int)(run + h3) >= mm) { fb = 4 * lane + 3; fm = mm - (int)run; } run += h3;
                      if (fb < 0 && (int)run < mm && (int)(run + h2) >= mm) { fb = 4 * lane + 2; fm = mm - (int)run; } run += h2;
                      if (fb < 0 && (int)run < mm && (int)(run + h1) >= mm) { fb = 4 * lane + 1; fm = mm - (int)run; } run += h1;
                      if (fb < 0 && (int)run < mm && (int)(run + h0) >= mm) { fb = 4 * lane; fm = mm - (int)run; } }
                    const unsigned long long bal = __ballot(fb >= 0); const int src = __builtin_ctzll(bal);
                    const int bin = __builtin_amdgcn_readlane(fb, src); mm = __builtin_amdgcn_readlane(fm, src);
                    prefix |= (unsigned)bin << shift; pmask |= 255u << shift;
                }
                for (unsigned c0 = 0; c0 < nc; c0 += 64) { const unsigned ci = c0 + lane; const bool have = ci < nc;
                    unsigned myk = 0u, myi = 0u; if (have) { myk = r0[(q * CAP + ci) * 2]; myi = r0[(q * CAP + ci) * 2 + 1]; }
                    bool take = have && myk > prefix;
                    const bool eq = have && myk == prefix;
                    if (__ballot(eq) != 0ull) { unsigned er = 0u; for (unsigned j = 0; j < nc; ++j) { const unsigned kj = r0[(q * CAP + j) * 2], ij = r0[(q * CAP + j) * 2 + 1]; er += (kj == prefix && ij < myi) ? 1u : 0u; }
                        take = take || (eq && (int)er < mm); }
                    if (take) { int hw, bit; idx_to_hwbit((int)myi, hw, bit);
                        __hip_atomic_fetch_or((LAS unsigned*)maskL + q * 128 + (hw >> 1), 1u << (bit + 16 * (hw & 1)), __ATOMIC_RELAXED, __HIP_MEMORY_SCOPE_WORKGROUP); } }
            }
            const int need = kk - (int)npos;
            if (haseq && nz != 0u && need > 0) {
                int mA = need - (int)before; mA = mA < 0 ? 0 : (mA > (int)cA ? (int)cA : mA);
                int mB = need - (int)before - (int)cA; mB = mB < 0 ? 0 : (mB > (int)cB ? (int)cB : mB);
                unsigned kA = 0u, kB = 0u, tA = wA, tB = wB;
                for (int m = 0; m < mA; ++m) { const unsigned lo = tA & (0u - tA); kA |= lo; tA ^= lo; }
                for (int m = 0; m < mB; ++m) { const unsigned lo = tB & (0u - tB); kB |= lo; tB ^= lo; }
                unsigned o0 = 0u, o1 = 0u;
#pragma unroll
                for (int g = 0; g < 4; ++g) { o0 |= (((kA >> (8 * g)) & 0xFu) << (4 * g)) | (((kB >> (8 * g)) & 0xFu) << (16 + 4 * g));
                                              o1 |= (((kA >> (8 * g + 4)) & 0xFu) << (4 * g)) | (((kB >> (8 * g + 4)) & 0xFu) << (16 + 4 * g)); }
                if (o0) __hip_atomic_fetch_or((LAS unsigned*)maskL + q * 128 + 2 * lane, o0, __ATOMIC_RELAXED, __HIP_MEMORY_SCOPE_WORKGROUP);
                if (o1) __hip_atomic_fetch_or((LAS unsigned*)maskL + q * 128 + 2 * lane + 1, o1, __ATOMIC_RELAXED, __HIP_MEMORY_SCOPE_WORKGROUP);
            }
        }
        __syncthreads();
        STS1(19, s4_); STS0(s5_);
        for (int qbase = 0; qbase < 32; ) {
            int nsl = 0, qnext = 32;
            __syncthreads();
            if (tid < 32) slotm[tid] = -1;
            __syncthreads();
            for (int q = qbase; q < 32; ++q) { if (flag[q] != 0u) { if (nsl == NSLOT3) { qnext = q; break; } if (tid == 0) slotm[q] = nsl; ++nsl; } }
            if (nsl == 0) break;
            __syncthreads();
            score_pass<3>(ikb, b, qt, wave, lane, bq, w0, w1, w2, w3, cq, r0, maskL, maskE, ccnt, eqf, 0, slotm[ql]);
            __syncthreads();
            for (int q = qbase; q < qnext; ++q) { const int sl = slotm[q]; if (sl >= 0) radix_row(r0 + sl * 4096, t0 + q + 1, lds, maskL + q * 256, tid); }
            qbase = qnext;
        }
        STS1(20, s5_);
    }
    __syncthreads();
    { const int q = tid >> 4, j = tid & 15; const LAS v4u* src = (const LAS v4u*)(maskL + q * 256) + 2 * j; GAS v4u* dst = (GAS v4u*)(mask + ((size_t)b * S_ + t0 + q) * 256) + 2 * j;
      dst[0] = src[0]; dst[1] = src[1]; }
}
}
constexpr int NWAVES = 8, NTHR = 512;
constexpr int NPROJ = 3584;
constexpr float C2 = 0.125f * 1.4426950408889634f;
constexpr int RING_BYTES = 131072, LDSCTL_OFF = RING_BYTES, MISC_OFF = LDSCTL_OFF + 320, LDS_BYTES = 147456;
constexpr int CW_TMO = 0, CW_CODE = 1, CW_BAR = 4096;
constexpr int N_PHASES = 11;
constexpr size_t MiB = 1u << 20;

struct FArgs { const float* in[16]; float* out; unsigned* ctl; float* mod; float* rope;
    f16 *win_t, *wout_t, *wgu_t, *wd_t; float *iw, *logf; unsigned* mask; float* ssq;
    f16 *iq, *ik, *h, *o, *qd, *kd, *vd, *qf, *kf, *vf, *act; int ph_lo, ph_hi, li, pad; };

__device__ __forceinline__ float wave_sum(float v) {
#pragma unroll
    for (int o = 1; o < 64; o <<= 1) v += __shfl_xor(v, o);
    return v;
}
__device__ __forceinline__ float fast_silu(float x) { return x * __builtin_amdgcn_rcpf(1.0f + __builtin_amdgcn_exp2f(-1.4426950408889634f * x)); }

__device__ __forceinline__ void tr_item(const float* W, int ldw, int K, int src_col0, f16* WT, int dst_row0, const float* kscale, LAS float* scr, int kb, int lane) {
    const int k0 = 64 * kb;
#pragma unroll 8
    for (int i = 0; i < 32; ++i) { const int kk = 2 * i + (lane >> 5); float v = W[(size_t)(k0 + kk) * ldw + src_col0 + (lane & 31)]; if (kscale) v *= kscale[k0 + kk]; scr[kk * 33 + (lane & 31)] = v; }
    LDS_WAIT(); asm volatile("" ::: "memory");
    const int c = lane & 7;
#pragma unroll
    for (int j = 0; j < 4; ++j) { const int n = (lane >> 3) + 8 * j; const LAS float* s = scr + (8 * c) * 33 + n;
        v4u o; o.x = pkh(s[0 * 33], s[1 * 33]); o.y = pkh(s[2 * 33], s[3 * 33]); o.z = pkh(s[4 * 33], s[5 * 33]); o.w = pkh(s[6 * 33], s[7 * 33]);
        *(GAS v4u*)(WT + (size_t)(dst_row0 + n) * K + k0 + 8 * c) = o; }
    LDS_WAIT(); asm volatile("" ::: "memory");
}

template <bool MODULATE, bool OUT_F16> __device__ __forceinline__ void norm_rows(const float* src, const float* g, const float* mod, int sh_off, int sc_off, f16* dst16, float* dst32, int gw, int ngw, int lane, float oscale = 1.0f) {
    for (int grp = gw; grp < M_ / 16; grp += ngw) {
        const int row0 = grp * 16, b = row0 / S_;
        f32x4 a[4], sh[4];
#pragma unroll
        for (int j = 0; j < 4; ++j) { a[j] = ((const f32x4*)g)[lane + 64 * j] * oscale;
            if (MODULATE) { const f32x4 sc = ((const f32x4*)(mod + b * NMOD + sc_off))[lane + 64 * j]; a[j] = a[j] * (sc + 1.0f); sh[j] = ((const f32x4*)(mod + b * NMOD + sh_off))[lane + 64 * j]; }
            else sh[j] = (f32x4){0.f, 0.f, 0.f, 0.f}; }
        for (int r = 0; r < 16; ++r) {
            const size_t roff = (size_t)(row0 + r) * D_;
            f32x4 v[4]; float ss = 0.f;
#pragma unroll
            for (int j = 0; j < 4; ++j) { v[j] = ((const GAS f32x4*)(src + roff))[lane + 64 * j]; ss += (v[j].x * v[j].x + v[j].y * v[j].y) + (v[j].z * v[j].z + v[j].w * v[j].w); }
            const float rstd = 1.0f / sqrtf(wave_sum(ss) * (1.0f / D_) + RMS_EPS);
#pragma unroll
            for (int j = 0; j < 4; ++j) { const f32x4 o = v[j] * rstd * a[j] + sh[j];
                if (OUT_F16) { v2u w; w.x = pkh(o.x, o.y); w.y = pkh(o.z, o.w); ((GAS v2u*)(dst16 + roff))[lane + 64 * j] = w; }
                else ((GAS f32x4*)(dst32 + roff))[lane + 64 * j] = o; }
        }
    }
}

struct EpiProj {
    static constexpr bool PERM = true, AFTER_DRAIN = false;
    f16 *qd, *kd, *vd, *qf, *kf, *vf, *iq, *ik; float *iw, *logf; const float* rope; const float* bfg;
    __device__ __forceinline__ void operator()(const f32x4 (&acc)[2][2][4][2], const pg8::Unit& u, int wr, int wc, int fr, int fq) const {
        const int pn = u.pn, row0 = u.pm * 256 + wr * 64 + fr;
        if (pn < 13) {
            f16* dst; int pitch = 512, colbase = (pn & 1) * 256; float scale = 1.f; bool rope_tile = false;
            if (pn < 12) { const int which = pn >> 1; dst = which == 0 ? qd : which == 1 ? kd : which == 2 ? vd : which == 3 ? qf : which == 4 ? kf : vf;
                if (which == 0 || which == 3) scale = C2; rope_tile = which < 2; }
            else { dst = iq; pitch = 256; colbase = 0; rope_tile = true; }
            const bool do_rope = rope_tile && ((wc & 1) == 0);
            const float sgn = (fq == 0) ? -1.f : 1.f;
#pragma unroll
            for (int ai = 0; ai < 2; ++ai)
#pragma unroll
                for (int m = 0; m < 4; ++m) { const int row = row0 + ai * 128 + m * 16;
                    f32x4 cs[4];
                    if (do_rope) {
#pragma unroll
                        for (int q = 0; q < 4; ++q) cs[q] = ((const f32x4*)(rope + (size_t)row * 16))[q]; }
#pragma unroll
                    for (int bj = 0; bj < 2; ++bj) { f32x4 v0 = acc[ai][bj][m][0], v1 = acc[ai][bj][m][1];
                        if (do_rope) {
                            f32x4 o0, o1;
#pragma unroll
                            for (int e = 0; e < 4; ++e) { o0[e] = __shfl_xor(v0[e], 16); o1[e] = __shfl_xor(v1[e], 16); }
                            if (fq < 2) {
                                v0[0] = v0[0] * cs[0][0] + sgn * o0[0] * cs[0][1]; v0[1] = v0[1] * cs[0][2] + sgn * o0[1] * cs[0][3];
                                v0[2] = v0[2] * cs[1][0] + sgn * o0[2] * cs[1][1]; v0[3] = v0[3] * cs[1][2] + sgn * o0[3] * cs[1][3];
                                v1[0] = v1[0] * cs[2][0] + sgn * o1[0] * cs[2][1]; v1[1] = v1[1] * cs[2][2] + sgn * o1[1] * cs[2][3];
                                v1[2] = v1[2] * cs[3][0] + sgn * o1[2] * cs[3][1]; v1[3] = v1[3] * cs[3][2] + sgn * o1[3] * cs[3][3]; }
                        }
                        v0 = v0 * scale; v1 = v1 * scale;
                        v4u w; w.x = pkh(v0[0], v0[1]); w.y = pkh(v0[2], v0[3]); w.z = pkh(v1[0], v1[1]); w.w = pkh(v1[2], v1[3]);
                        *(GAS v4u*)(dst + (size_t)row * pitch + colbase + bj * 128 + wc * 32 + 8 * fq) = w; } }
        } else {
            const bool do_rope = (wc == 0);
            const float sgn = (fq == 0) ? -1.f : 1.f;
#pragma unroll
            for (int ai = 0; ai < 2; ++ai)
#pragma unroll
                for (int m = 0; m < 4; ++m) { const int row = row0 + ai * 128 + m * 16;
                    f32x4 v0 = acc[ai][0][m][0], v1 = acc[ai][0][m][1];
                    if (wc < 2) {
                        if (do_rope) {
                            f32x4 cs[4];
#pragma unroll
                            for (int q = 0; q < 4; ++q) cs[q] = ((const f32x4*)(rope + (size_t)row * 16))[q];
                            f32x4 o0, o1;
#pragma unroll
                            for (int e = 0; e < 4; ++e) { o0[e] = __shfl_xor(v0[e], 16); o1[e] = __shfl_xor(v1[e], 16); }
                            if (fq < 2) {
                                v0[0] = v0[0] * cs[0][0] + sgn * o0[0] * cs[0][1]; v0[1] = v0[1] * cs[0][2] + sgn * o0[1] * cs[0][3];
                                v0[2] = v0[2] * cs[1][0] + sgn * o0[2] * cs[1][1]; v0[3] = v0[3] * cs[1][2] + sgn * o0[3] * cs[1][3];
                                v1[0] = v1[0] * cs[2][0] + sgn * o1[0] * cs[2][1]; v1[1] = v1[1] * cs[2][2] + sgn * o1[1] * cs[2][3];
                                v1[2] = v1[2] * cs[3][0] + sgn * o1[2] * cs[3][1]; v1[3] = v1[3] * cs[3][2] + sgn * o1[3] * cs[3][3]; }
                        }
                        v4u w; w.x = pkh(v0[0], v0[1]); w.y = pkh(v0[2], v0[3]); w.z = pkh(v1[0], v1[1]); w.w = pkh(v1[2], v1[3]);
                        *(GAS v4u*)(ik + (size_t)row * 64 + wc * 32 + 8 * fq) = w;
                    } else if (wc == 2) {
                        if (fq == 0) { *(GAS f32x4*)(iw + (size_t)row * 4) = v0 * 0.5f; }
                        else if (fq == 1) {
                            const f32x4 b0 = ((const f32x4*)bfg)[0], b1 = ((const f32x4*)bfg)[1]; f32x4 z0 = v0 + b0, z1 = v1 + b1, l0, l1;
#pragma unroll
                            for (int e = 0; e < 4; ++e) { l0[e] = fminf(z0[e], 0.f) - log1pf(expf(-fabsf(z0[e]))); l1[e] = fminf(z1[e], 0.f) - log1pf(expf(-fabsf(z1[e]))); }
                            *(GAS f32x4*)(logf + (size_t)row * 8) = l0; *(GAS f32x4*)(logf + (size_t)row * 8 + 4) = l1; }
                    }
                }
        }
    }
};
struct EpiGateUp {
    static constexpr bool PERM = true, AFTER_DRAIN = false; f16* act;
    __device__ __forceinline__ void operator()(const f32x4 (&acc)[2][2][4][2], const pg8::Unit& u, int wr, int wc, int fr, int fq) const {
        const int row0 = u.pm * 256 + wr * 64 + fr, col0 = u.pn * 128 + wc * 32 + 8 * fq;
#pragma unroll
        for (int ai = 0; ai < 2; ++ai)
#pragma unroll
            for (int m = 0; m < 4; ++m) { const f32x4 g0 = acc[ai][0][m][0], g1 = acc[ai][0][m][1], u0 = acc[ai][1][m][0], u1 = acc[ai][1][m][1];
                v4u w; w.x = pkh(fast_silu(g0[0]) * u0[0], fast_silu(g0[1]) * u0[1]); w.y = pkh(fast_silu(g0[2]) * u0[2], fast_silu(g0[3]) * u0[3]);
                w.z = pkh(fast_silu(g1[0]) * u1[0], fast_silu(g1[1]) * u1[1]); w.w = pkh(fast_silu(g1[2]) * u1[2], fast_silu(g1[3]) * u1[3]);
                *(GAS v4u*)(act + (size_t)(row0 + ai * 128 + m * 16) * DFF + col0) = w; }
    }
};
struct EpiRes {
    static constexpr bool PERM = true, AFTER_DRAIN = false; const float* base; float* out; const float* gvec;
    __device__ __forceinline__ void operator()(const f32x4 (&acc)[2][2][4][2], const pg8::Unit& u, int wr, int wc, int fr, int fq) const {
        const int row0 = u.pm * 256 + wr * 64 + fr, b = (u.pm * 256) / S_;
#pragma unroll
        for (int bj = 0; bj < 2; ++bj) { const int col = u.pn * 256 + bj * 128 + wc * 32 + 8 * fq;
            const f32x4 gv0 = *(const f32x4*)(gvec + b * NMOD + col), gv1 = *(const f32x4*)(gvec + b * NMOD + col + 4);
#pragma unroll
            for (int ai = 0; ai < 2; ++ai)
#pragma unroll
                for (int m = 0; m < 4; ++m) { const size_t off = (size_t)(row0 + ai * 128 + m * 16) * D_ + col;
                    const f32x4 x0 = *(const GAS f32x4*)(base + off), x1 = *(const GAS f32x4*)(base + off + 4);
                    *(GAS f32x4*)(out + off) = x0 + gv0 * acc[ai][bj][m][0]; *(GAS f32x4*)(out + off + 4) = x1 + gv1 * acc[ai][bj][m][1]; } }
    }
};

__global__ void __launch_bounds__(NTHR, 2) fwd(FArgs A0) {
    extern __shared__ __attribute__((aligned(16))) unsigned char lds_raw[];
    LAS unsigned char* lds = (LAS unsigned char*)lds_raw;
    volatile LAS unsigned* MISC = (volatile LAS unsigned*)(lds + MISC_OFF);
    const int tid0 = threadIdx.x, wave = __builtin_amdgcn_readfirstlane(tid0 >> 6);
#define PHASE_IDS int tid = threadIdx.x; asm volatile("" : "+v"(tid)); const int lane = tid & 63; (void)lane; \
    const __attribute__((address_space(4))) FArgs* Ap_ = (const __attribute__((address_space(4))) FArgs*)__builtin_amdgcn_kernarg_segment_ptr(); asm volatile("" : "+s"(Ap_)); const __attribute__((address_space(4))) FArgs& A = *Ap_;
    const int G = gridDim.x; const int bx = blockIdx.x; const int vcu = (G % 8 == 0) ? (bx % 8) * (G / 8) + bx / 8 : bx;
    const int gw = vcu * NWAVES + wave, NGW = G * NWAVES;
    for (int u = tid0; u < (LDS_BYTES - LDSCTL_OFF) / 4; u += NTHR) ((LAS unsigned*)(lds + LDSCTL_OFF))[u] = 0u;
    __syncthreads();
    XcdBarrier bar = xcd_barrier_post(A0.ctl + CW_BAR + A0.li * XCD_BAR_WORDS, MISC + 8);
    const int lo = A0.ph_lo, hi = A0.ph_hi;
#ifdef TPROBE
    LAS unsigned* tsl = (LAS unsigned*)(lds + LDSCTL_OFF + 64);
#define TS0(v) unsigned long long v = __builtin_amdgcn_s_memrealtime()
#define TS1(slot, v) do { if (threadIdx.x == 0) tsl[slot] += (unsigned)(__builtin_amdgcn_s_memrealtime() - (v)); } while (0)
#else
#define TS0(v) do {} while (0)
#define TS1(slot, v) do {} while (0)
#endif
#define IN(k) (lo <= (k) && (k) < hi)
#define BOTH(k) (IN(k) && IN((k) + 1))
#define GRID_BAR() do { TS0(tb_); xcd_barrier(bar); TS1(10, tb_); } while (0)


    if (IN(0)) { PHASE_IDS TS0(tp_);
        LAS float* scr = (LAS float*)(lds + wave * 16384);
        constexpr int I_IN = 106 * 16, I_OUT = 32 * 16, I_G = 88 * 16, I_D = 32 * 44, NITEMS = I_IN + I_OUT + 2 * I_G + I_D;
        for (int it = gw; it < NITEMS; it += NGW) {
            int r = it;
            if (r < I_IN) { const int nb = r >> 4, kb = r & 15; int dst, src;
                if (nb < 48) { dst = 32 * nb; src = 32 * nb; } else if (nb < 96) { dst = 1536 + 32 * (nb - 48); src = C_QF + 32 * (nb - 48); }
                else if (nb < 104) { dst = 3072 + 32 * (nb - 96); src = C_IQ + 32 * (nb - 96); } else { dst = 3328 + 32 * (nb - 104); src = C_IK + 32 * (nb - 104); }
                tr_item(A.in[6], DIN, D_, src, A.win_t, dst, nullptr, scr, kb, lane); continue; } r -= I_IN;
            if (r < I_OUT) { const int nb = r >> 4, kb = r & 15; tr_item(A.in[10], D_, D_, 32 * nb, A.wout_t, 32 * nb, (A.pad & 1) ? nullptr : (kb < 8 ? A.in[8] : A.in[9] - 512), scr, kb, lane); continue; } r -= I_OUT;
            if (r < I_G) { const int nb = r >> 4, kb = r & 15; tr_item(A.in[12], DFF, D_, 32 * nb, A.wgu_t, 256 * (nb >> 2) + 32 * (nb & 3), nullptr, scr, kb, lane); continue; } r -= I_G;
            if (r < I_G) { const int nb = r >> 4, kb = r & 15; tr_item(A.in[13], DFF, D_, 32 * nb, A.wgu_t, 256 * (nb >> 2) + 128 + 32 * (nb & 3), nullptr, scr, kb, lane); continue; } r -= I_G;
            { const int nb = r / 44, kb = r % 44; tr_item(A.in[14], D_, DFF, 32 * nb, A.wd_t, 32 * nb, nullptr, scr, kb, lane); }
        }
        for (int e = vcu * NTHR + tid; e < 192 * D_; e += G * NTHR) { const int np = 64 + e / D_, k = e % D_;
            const int src = (np < 68) ? C_IW + np - 64 : (np >= 72 && np < 80) ? C_FG + np - 72 : -1;
            A.win_t[(size_t)(3328 + np) * D_ + k] = src >= 0 ? (f16)A.in[6][(size_t)k * DIN + src] : (f16)0.f; }
        for (int e = vcu * NTHR + tid; e < M_ * 8; e += G * NTHR) { const int row = e >> 3, i = e & 7;
            const float inv = (float)pow(500000.0, -(double)i / 8.0); const float angf = (float)((const int*)A.in[2])[row] * inv;
            A.rope[2 * e] = (float)cos((double)angf); A.rope[2 * e + 1] = (float)sin((double)angf); }
        __syncthreads();
        for (int slot = vcu; slot < NMOD / 32; slot += G) {
            LAS float* ca = (LAS float*)lds; LAS float* red = ca + 8192;
            for (int i = tid; i < 8192; i += NTHR) { const float v = A.in[1][i]; ca[i] = v / (1.f + expf(-v)); }
            __syncthreads();
            const int kg = tid >> 5, cc = tid & 31, n = slot * 32 + cc;
            float acc[8];
#pragma unroll
            for (int b = 0; b < 8; ++b) acc[b] = 0.f;
            for (int k = kg; k < D_; k += 16) { const float w = A.in[3][(size_t)k * NMOD + n];
#pragma unroll
                for (int b = 0; b < 8; ++b) acc[b] += ca[b * 1024 + k] * w; }
#pragma unroll
            for (int b = 0; b < 8; ++b) red[(kg * 8 + b) * 32 + cc] = acc[b];
            __syncthreads();
            if (tid < 256) { const int b = tid >> 5; float s = 0.f;
#pragma unroll
                for (int k2 = 0; k2 < 16; ++k2) s += red[(k2 * 8 + b) * 32 + cc];
                A.mod[b * NMOD + n] = s + A.in[4][n]; }
            __syncthreads();
        }
        TS1(0, tp_); if (BOTH(0)) GRID_BAR();
    }
    if (IN(1)) { PHASE_IDS TS0(tp_); norm_rows<true, true>(A.in[0], A.in[5], A.mod, 0, 1024, A.h, nullptr, gw, NGW, lane); TS1(1, tp_); if (BOTH(1)) GRID_BAR(); }
    if (IN(2)) { PHASE_IDS TS0(tp_);
        pg8::Gemm g{(const pg8::bf16_t*)A.h, (const pg8::bf16_t*)A.win_t, M_, NPROJ, D_}; pg8::StaticOrder S; S.init(M_, NPROJ, G, bx);
        EpiProj E{A.qd, A.kd, A.vd, A.qf, A.kf, A.vf, A.iq, A.ik, A.iw, A.logf, A.rope, A.in[7]};
        pg8::gemm_phase<EpiProj, pg8::StaticOrder, true, true>(lds, g, S, E);
        TS1(2, tp_); if (BOTH(2)) GRID_BAR();
    }
    if (IN(3)) { PHASE_IDS TS0(tp_);
        (void)tid;
        for (int uid = vcu; uid < 1024; uid += G) { const int v = uid & 255, i = uid >> 8, sb = v >> 5, s5 = v & 31; const int qt = (i == 0) ? s5 : (i == 1) ? 63 - s5 : (i == 2) ? 64 + s5 : 127 - s5;
            sel::select_unit(A.iq, A.ik, A.iw, (unsigned short*)A.mask, sb, qt, lds, wave, (LAS unsigned*)(lds + LDSCTL_OFF + 64)); }
        TS1(3, tp_); if (BOTH(3)) GRID_BAR();
    }
    if (IN(4)) { PHASE_IDS TS0(tp_);
        char* shm = (char*)lds_raw;
        for (int uid = vcu; uid < 1024; uid += G) { const int v = uid & 255, i = uid >> 8, bh = v >> 2, s4 = v & 3; const int qb = (i == 0) ? s4 : (i == 1) ? 7 - s4 : (i == 2) ? 8 + s4 : 15 - s4;
            attn_body::attn_unit<8, 1>(bh >> 3, bh & 7, qb, A.qd, A.kd, A.vd, A.o, A.ssq, 0, nullptr, A.mask, shm); }
        TS1(22, tp_); TS0(tf_);
        LAS float* biasL = (LAS float*)(lds + 86016); LAS float* wtot = biasL + 4096; int cur_bh = -1;
        for (int uid = vcu; uid < 1024; uid += G) { const int v = uid & 255, i = uid >> 8, bh = v >> 2, s4 = v & 3; const int qb = (i == 0) ? s4 : (i == 1) ? 7 - s4 : (i == 2) ? 8 + s4 : 15 - s4;
            if (bh != cur_bh) {
                cur_bh = bh; __syncthreads();
                int tl = threadIdx.x; asm volatile("" : "+v"(tl)); const int ln = tl & 63;
                const int base = tl * 8; float pv[8]; float run = 0.f;
#pragma unroll
                for (int e = 0; e < 8; ++e) { run += A.logf[(size_t)((bh >> 3) * S_ + base + e) * 8 + (bh & 7)]; pv[e] = run; }
                float incl = run;
#pragma unroll
                for (int o = 1; o < 64; o <<= 1) { const int src = ln - o; const float y = __int_as_float(__builtin_amdgcn_ds_bpermute((src < 0 ? ln : src) << 2, __float_as_int(incl))); if (ln >= o) incl += y; }
                if (ln == 63) wtot[wave] = incl;
                __syncthreads();
                float woff = 0.f; for (int w2 = 0; w2 < wave; ++w2) woff += wtot[w2];
                const float excl = woff + incl - run;
#pragma unroll
                for (int e = 0; e < 8; ++e) biasL[base + e] = -(excl + pv[e]) * 1.4426950408889634f;
                __syncthreads();
            }
            attn_body::attn_unit<8, 0>(bh >> 3, bh & 7, qb, A.qf, A.kf, A.vf, A.o, A.ssq, 1, (attn_body::lds_cfptr)biasL, nullptr, shm); }
        TS1(23, tf_); TS1(4, tp_); if (BOTH(4)) GRID_BAR();
    }
    if (IN(5)) { PHASE_IDS TS0(tp_);
        for (int grp = gw; grp < M_ / 16; grp += NGW) {
            for (int r = 0; r < 16; ++r) { const int row = grp * 16 + r;
                float sv = A.ssq[(size_t)(lane & 15) * M_ + row];
                sv += __shfl_xor(sv, 1); sv += __shfl_xor(sv, 2); sv += __shfl_xor(sv, 4);
                const float rd = 1.0f / sqrtf(__shfl(sv, 0) * (1.0f / 512.f) + RMS_EPS), rf = 1.0f / sqrtf(__shfl(sv, 8) * (1.0f / 512.f) + RMS_EPS);
#pragma unroll
                for (int j = 0; j < 2; ++j) { const int ch = lane + 64 * j; GAS v4u* p = (GAS v4u*)(A.o + (size_t)row * D_) + ch; const v4u w = *p; const float rs = ch < 64 ? rd : rf;
                    typedef _Float16 h2 __attribute__((ext_vector_type(2)));
                    v4u o;
#pragma unroll
                    for (int e = 0; e < 4; ++e) { const unsigned we = w[e]; const h2 hv = __builtin_bit_cast(h2, we); o[e] = pkh((float)hv[0] * rs, (float)hv[1] * rs); }
                    *p = o; }
            }
        }
        TS1(5, tp_); if (BOTH(5)) GRID_BAR();
    }
    if (IN(6)) { PHASE_IDS TS0(tp_);
        pg8::Gemm g{(const pg8::bf16_t*)A.o, (const pg8::bf16_t*)A.wout_t, M_, D_, D_}; pg8::StaticOrder S; S.init(M_, D_, G, bx);
        EpiRes E{A.in[0], A.out, A.mod + 2048};
        pg8::gemm_phase<EpiRes, pg8::StaticOrder, true, true>(lds, g, S, E);
        TS1(6, tp_); if (BOTH(6)) GRID_BAR();
    }
    if (IN(7)) { PHASE_IDS TS0(tp_); norm_rows<true, true>(A.out, A.in[11], A.mod, 3072, 4096, A.h, nullptr, gw, NGW, lane); TS1(7, tp_); if (BOTH(7)) GRID_BAR(); }
    if (IN(8)) { PHASE_IDS TS0(tp_);
        pg8::Gemm g{(const pg8::bf16_t*)A.h, (const pg8::bf16_t*)A.wgu_t, M_, 2 * DFF, D_}; pg8::StaticOrder S; S.init(M_, 2 * DFF, G, bx);
        EpiGateUp E{A.act};
        pg8::gemm_phase<EpiGateUp, pg8::StaticOrder, true, true>(lds, g, S, E);
        TS1(8, tp_); if (BOTH(8)) GRID_BAR();
    }
    if (IN(9)) { PHASE_IDS TS0(tp_);
        pg8::Gemm g{(const pg8::bf16_t*)A.act, (const pg8::bf16_t*)A.wd_t, M_, D_, DFF}; pg8::StaticOrder S; S.init(M_, D_, G, bx);
        EpiRes E{A.out, A.out, A.mod + 5120};
        pg8::gemm_phase<EpiRes, pg8::StaticOrder, true, true>(lds, g, S, E);
        TS1(9, tp_);
#ifdef TPROBE
        __syncthreads(); if (threadIdx.x < 32) __hip_atomic_fetch_max(A.ctl + 2048 + threadIdx.x, tsl[threadIdx.x], __ATOMIC_RELAXED, __HIP_MEMORY_SCOPE_AGENT);
#endif
        if (BOTH(9)) GRID_BAR();
    }
    if (IN(10)) { PHASE_IDS
        float oscale = 1.0f;
#ifdef TPROBE
        oscale = 1.0f + sqrtf((float)__hip_atomic_load(A.ctl + 2048 + TPROBE, __ATOMIC_RELAXED, __HIP_MEMORY_SCOPE_AGENT) * 1e-2f * 1e-5f);
#endif
        norm_rows<false, false>(A.out, A.in[15], nullptr, 0, 0, nullptr, A.out, gw, NGW, lane, oscale); }
#undef IN
#undef BOTH
#undef GRID_BAR
}
__device__ __forceinline__ void mask_pos(int s, int& hw, int& bit) { const int j = s >> 5, w = s & 31, hi = (w >> 2) & 1; bit = (w & 3) | ((w >> 3) << 2); hw = (((j >> 1) * 2 + hi) * 2 + (j & 1)); }

__global__ void __launch_bounds__(64) nk_cumsum2(const float* logf, float* cum) {
    const int b = blockIdx.x >> 3, h = blockIdx.x & 7, l = threadIdx.x;
    const float* src = logf + (size_t)(b * S_ + 64 * l) * 8 + h;
    double s = 0.0;
    for (int i = 0; i < 64; ++i) s += (double)src[(size_t)i * 8];
    double incl = s;
    for (int o = 1; o < 64; o <<= 1) { const double v = __shfl_up(incl, o); if (l >= o) incl += v; }
    double run = incl - s;
    for (int i = 0; i < 64; ++i) { run += (double)src[(size_t)i * 8]; cum[(size_t)(b * S_ + 64 * l + i) * 8 + h] = (float)run; }
}

__global__ void __launch_bounds__(256) nk_select2(const f16* iqb, const f16* ikb, const float* iwb, unsigned short* mask) {
    __shared__ float iq[256]; __shared__ float iw[4]; __shared__ unsigned key[4096]; __shared__ unsigned hist[256]; __shared__ int sh_bin, sh_kk; __shared__ unsigned cnt[256]; __shared__ unsigned char sel[4096];
    const int t = blockIdx.x, b = blockIdx.y, tid = threadIdx.x, row = b * S_ + t, n = t + 1;
    unsigned short* mrow = mask + (size_t)row * 256;
    if (n <= 256) { for (int i = 0; i < 16; ++i) sel[tid * 16 + i] = (tid * 16 + i) < n ? 1 : 0; }
    else {
    iq[tid] = (float)iqb[(size_t)row * 256 + tid]; if (tid < 4) iw[tid] = iwb[(size_t)row * 4 + tid];
    __syncthreads();
#pragma unroll 1
    for (int s = tid; s < n; s += 256) {
        asm volatile("" ::: "memory");
        const f16* kr = ikb + (size_t)(b * S_ + s) * 64;
        float d[4] = {0.f, 0.f, 0.f, 0.f};
#pragma unroll
        for (int j = 0; j < 64; ++j) { const float kv = (float)kr[j];
#pragma unroll
            for (int h = 0; h < 4; ++h) d[h] += iq[h * 64 + j] * kv; }
        float sc = 0.f;
#pragma unroll
        for (int h = 0; h < 4; ++h) sc += fmaxf(d[h] * 0.125f, 0.f) * iw[h];
        key[s] = mono_key(sc);
    }
    __syncthreads();
    unsigned prefix = 0u, pmask = 0u; int kk = 256;
    for (int shift = 24; shift >= 0; shift -= 8) {
        hist[tid] = 0u; __syncthreads();
        for (int s = tid; s < n; s += 256) { const unsigned k = key[s]; if ((k & pmask) == prefix) atomicAdd(&hist[(k >> shift) & 255u], 1u); }
        __syncthreads();
        if (tid == 0) { int c = 0, bin = 255; while (bin > 0 && c + (int)hist[bin] < kk) { c += (int)hist[bin]; --bin; } sh_bin = bin; sh_kk = kk - c; }
        __syncthreads();
        prefix |= (unsigned)sh_bin << shift; pmask |= 255u << shift; kk = sh_kk;
        __syncthreads();
    }
    unsigned ceq = 0u;
    for (int i = 0; i < 16; ++i) { const int s = tid * 16 + i; if (s < n && key[s] == prefix) ++ceq; }
    cnt[tid] = ceq; __syncthreads();
    unsigned before = 0u; for (int j = 0; j < tid; ++j) before += cnt[j];
    for (int i = 0; i < 16; ++i) { const int s = tid * 16 + i; unsigned char v = 0; if (s < n) { const unsigned k = key[s];
        if (k > prefix) v = 1; else if (k == prefix) { if ((int)before < kk) v = 1; ++before; } } sel[s] = v; }
    }
    __syncthreads();
    { const int hw = tid, J = hw >> 2, hi = (hw >> 1) & 1, j = 2 * J + (hw & 1); unsigned bits = 0u;
      for (int r = 0; r < 16; ++r) { const int s = 32 * j + (r & 3) + 8 * (r >> 2) + 4 * hi; if (sel[s]) bits |= 1u << r; }
      mrow[hw] = (unsigned short)bits; }
}

template <int MODE> __global__ void __launch_bounds__(256) nk_attn2(const f16* Q, const f16* K, const f16* V, const float* cum, const unsigned short* mask, float* o, int ooff) {
    __shared__ float lg[4096]; __shared__ float qs[64]; __shared__ float red[256];
    const int t = blockIdx.x, h = blockIdx.y, b = blockIdx.z, tid = threadIdx.x, row = b * S_ + t, n = t + 1;
    if (tid < 64) qs[tid] = (float)Q[(size_t)row * 512 + h * 64 + tid];
    __syncthreads();
    const float cq = (MODE == 0) ? cum[(size_t)row * 8 + h] : 0.f;
    float mx = -INFINITY;
    for (int s = tid; s < n; s += 256) {
        const f16* kr = K + (size_t)(b * S_ + s) * 512 + h * 64;
        float d = 0.f;
#pragma unroll
        for (int j = 0; j < 64; ++j) d += qs[j] * (float)kr[j];
        d *= 0.6931471805599453f;
        if (MODE == 0) d += cq - cum[(size_t)(b * S_ + s) * 8 + h];
        else { int hw, bit; mask_pos(s, hw, bit); if (!((mask[(size_t)row * 256 + hw] >> bit) & 1u)) d = -INFINITY; }
        lg[s] = d; mx = fmaxf(mx, d);
    }
    __syncthreads();
    mx = block_max256(mx, red);
    float sum = 0.f;
    for (int s = tid; s < n; s += 256) { const float p = expf(lg[s] - mx); lg[s] = p; sum += p; }
    __syncthreads();
    sum = block_sum256(sum, red);
    const int d = tid & 63, g = tid >> 6; float acc = 0.f;
    for (int s = g; s < n; s += 4) acc += lg[s] * (float)V[(size_t)(b * S_ + s) * 512 + h * 64 + d];
    red[tid] = acc; __syncthreads();
    if (tid < 64) o[(size_t)row * D_ + ooff + h * 64 + tid] = (red[tid] + red[tid + 64] + red[tid + 128] + red[tid + 192]) / sum;
}

__global__ void __launch_bounds__(256) nk_o_bridge(const float* o, f16* O, float* ssq) {
    __shared__ float red[256];
    const int row = blockIdx.x, tid = threadIdx.x;
    float s = 0.f;
    for (int i = 0; i < 4; ++i) { const int c = tid * 4 + i; const f16 hv = (f16)o[(size_t)row * D_ + c]; O[(size_t)row * D_ + c] = hv; const float f = (float)hv; s += f * f; }
    red[tid] = s; __syncthreads();
    if (tid < 16) { float a = 0.f; for (int j = 0; j < 16; ++j) a += red[tid * 16 + j]; ssq[(size_t)tid * M_ + row] = a; }
}
static int fwd_grid() {
    static int grid = 0;
    if (grid == 0) {
        int dev = 0, cus = 0, per_cu = 0;
        if (hipGetDevice(&dev) != hipSuccess || hipDeviceGetAttribute(&cus, hipDeviceAttributeMultiprocessorCount, dev) != hipSuccess) { fprintf(stderr, "kernel_launch: device query failed\n"); grid = -1; return grid; }
        if (hipFuncSetAttribute((const void*)fwd, hipFuncAttributeMaxDynamicSharedMemorySize, LDS_BYTES) != hipSuccess) { fprintf(stderr, "kernel_launch: hipFuncSetAttribute failed\n"); grid = -1; return grid; }
        if (hipOccupancyMaxActiveBlocksPerMultiprocessor(&per_cu, (const void*)fwd, NTHR, LDS_BYTES) != hipSuccess || per_cu < 1) fprintf(stderr, "kernel_launch: occupancy query reports %d blocks per CU\n", per_cu);
        (void)hipGetLastError();
        grid = cus;
    }
    return grid;
}
static void launch_fwd(FArgs a, int lo, int hi, int li, int grid, hipStream_t stream) {
    a.ph_lo = lo; a.ph_hi = hi; a.li = li; a.pad = 0;
    hipLaunchKernelGGL(fwd, dim3(grid), dim3(NTHR), LDS_BYTES, stream, a);
}
static void fill_args(FArgs& a, void* const* d_in, void* d_out, unsigned char* ws) {
    memset(&a, 0, sizeof(a));
    for (int i = 0; i < 16; ++i) a.in[i] = (const float*)d_in[i];
    a.out = (float*)d_out; a.ctl = (unsigned*)(ws); a.mod = (float*)(ws + 1 * MiB); a.rope = (float*)(ws + 2 * MiB);
    a.win_t = (f16*)(ws + 4 * MiB); a.wout_t = (f16*)(ws + 11 * MiB); a.wgu_t = (f16*)(ws + 13 * MiB); a.wd_t = (f16*)(ws + 24 * MiB);
    a.iw = (float*)(ws + 30 * MiB); a.logf = (float*)(ws + 31 * MiB); a.mask = (unsigned*)(ws + 32 * MiB); a.ssq = (float*)(ws + 48 * MiB);
    a.iq = (f16*)(ws + 50 * MiB); a.ik = (f16*)(ws + 66 * MiB); a.h = (f16*)(ws + 70 * MiB); a.o = (f16*)(ws + 134 * MiB);
    a.qd = (f16*)(ws + 198 * MiB); a.kd = (f16*)(ws + 230 * MiB); a.vd = (f16*)(ws + 262 * MiB); a.qf = (f16*)(ws + 294 * MiB); a.kf = (f16*)(ws + 326 * MiB); a.vf = (f16*)(ws + 358 * MiB);
    a.act = (f16*)(ws + 198 * MiB);
}

extern "C" void kernel_launch(void* const* d_in, const int* in_sizes, int n_in, void* d_out, int out_size, void* d_ws, size_t ws_size, hipStream_t stream) {
    if (ws_size < 512 * MiB || n_in != 16 || out_size != M_ * D_) { fprintf(stderr, "kernel_launch: unexpected sizes ws %zu n_in %d out %d\n", ws_size, n_in, out_size); return; }
    const int grid = fwd_grid(); if (grid < 0) return;
    unsigned char* ws = (unsigned char*)d_ws; float* out = (float*)d_out;
    FArgs a; fill_args(a, d_in, d_out, ws);
    hipMemsetAsync(a.ctl, 0, 1 * MiB, stream);
#ifdef DUP_K
    launch_fwd(a, 0, DUP_K + 1, 0, grid, stream);
    launch_fwd(a, DUP_K, 11, 1, grid, stream);
#else
    launch_fwd(a, 0, 11, 0, grid, stream);
#endif
}
```

```cpp
#include <hip/hip_runtime.h>
#include <cstdio>
#include <cstdint>
#include <cmath>
#include <cstring>

constexpr int B_ = 8, S_ = 4096, D_ = 1024, M_ = B_ * S_, DIN = 3404, DFF = 2816, NMOD = 6144;
constexpr int C_QD = 0, C_KD = 512, C_VD = 1024, C_IQ = 1536, C_IK = 1792, C_IW = 1856, C_QF = 1860, C_KF = 2372, C_VF = 2884, C_FG = 3396;
constexpr float RMS_EPS = 1e-6f;

__device__ __forceinline__ float block_sum256(float v, float* red) {
    const int tid = threadIdx.x;
    red[tid] = v; __syncthreads();
    for (int o = 128; o > 0; o >>= 1) { if (tid < o) red[tid] += red[tid + o]; __syncthreads(); }
    const float r = red[0]; __syncthreads(); return r;
}
__device__ __forceinline__ float block_max256(float v, float* red) {
    const int tid = threadIdx.x;
    red[tid] = v; __syncthreads();
    for (int o = 128; o > 0; o >>= 1) { if (tid < o) red[tid] = fmaxf(red[tid], red[tid + o]); __syncthreads(); }
    const float r = red[0]; __syncthreads(); return r;
}

__global__ void __launch_bounds__(256) nk_mod(const float* c, const float* aw, const float* ab, float* mod) {
    __shared__ float ca[8][1024];
    const int tid = threadIdx.x, n = blockIdx.x * 256 + tid;
    for (int i = tid; i < 8192; i += 256) { const float v = c[i]; ca[i >> 10][i & 1023] = v / (1.f + expf(-v)); }
    __syncthreads();
    float acc[8];
#pragma unroll
    for (int b = 0; b < 8; ++b) acc[b] = 0.f;
    for (int k = 0; k < 1024; ++k) { const float w = aw[(size_t)k * NMOD + n];
#pragma unroll
        for (int b = 0; b < 8; ++b) acc[b] += ca[b][k] * w; }
#pragma unroll
    for (int b = 0; b < 8; ++b) mod[b * NMOD + n] = acc[b] + ab[n];
}

__global__ void __launch_bounds__(256) nk_norm_mod(const float* x, const float* g, const float* mod, int sh_off, int sc_off, float* out) {
    __shared__ float red[256];
    const int row = blockIdx.x, tid = threadIdx.x, b = row / S_;
    const float4 v = ((const float4*)(x + (size_t)row * D_))[tid];
    const float ss = block_sum256(v.x * v.x + v.y * v.y + v.z * v.z + v.w * v.w, red);
    const float rstd = 1.0f / sqrtf(ss * (1.0f / D_) + RMS_EPS);
    const float4 gg = ((const float4*)g)[tid];
    float4 o = {v.x * rstd * gg.x, v.y * rstd * gg.y, v.z * rstd * gg.z, v.w * rstd * gg.w};
    if (mod) {
        const float4 sc = ((const float4*)(mod + b * NMOD + sc_off))[tid], sh = ((const float4*)(mod + b * NMOD + sh_off))[tid];
        o.x = o.x * (1.f + sc.x) + sh.x; o.y = o.y * (1.f + sc.y) + sh.y; o.z = o.z * (1.f + sc.z) + sh.z; o.w = o.w * (1.f + sc.w) + sh.w;
    }
    ((float4*)(out + (size_t)row * D_))[tid] = o;
}

enum { EPI_PLAIN = 0, EPI_RES = 1, EPI_GATEUP = 2 };
struct GemmArgs { const float* A; const float* W; const float* W2; float* C; const float* base; const float* mod; int lda, ldw, M, N, K, ldc, g_off, pad; };
static GemmArgs mk_gemm(const float* A, int lda, const float* W, const float* W2, int ldw, int M, int N, int K, float* C, int ldc, const float* base, const float* mod, int g_off) {
    GemmArgs g; memset(&g, 0, sizeof(g)); g.A = A; g.W = W; g.W2 = W2; g.C = C; g.base = base; g.mod = mod; g.lda = lda; g.ldw = ldw; g.M = M; g.N = N; g.K = K; g.ldc = ldc; g.g_off = g_off; g.pad = 0; return g; }
template <int EPI> __global__ void __launch_bounds__(256) nk_gemm(GemmArgs a) {
    __shared__ float As[16][65];
    __shared__ float Ws[16][64];
    __shared__ float Ws2[EPI == EPI_GATEUP ? 16 : 1][64];
    const int tid = threadIdx.x, tx = tid & 15, ty = tid >> 4, m0 = blockIdx.y * 64, n0 = blockIdx.x * 64;
    float acc[4][4], acc2[4][4];
#pragma unroll
    for (int i = 0; i < 4; ++i)
#pragma unroll
        for (int j = 0; j < 4; ++j) { acc[i][j] = 0.f; acc2[i][j] = 0.f; }
    for (int k0 = 0; k0 < a.K; k0 += 16) {
#pragma unroll
        for (int i = 0; i < 4; ++i) { const int idx = tid + i * 256, r = idx >> 4, kk = idx & 15; As[kk][r] = a.A[(size_t)(m0 + r) * a.lda + k0 + kk]; }
#pragma unroll
        for (int i = 0; i < 4; ++i) { const int idx = tid + i * 256, kk = idx >> 6, c = idx & 63; const bool ok = (n0 + c) < a.N;
            Ws[kk][c] = ok ? a.W[(size_t)(k0 + kk) * a.ldw + n0 + c] : 0.f;
            if (EPI == EPI_GATEUP) Ws2[kk][c] = ok ? a.W2[(size_t)(k0 + kk) * a.ldw + n0 + c] : 0.f; }
        __syncthreads();
#pragma unroll
        for (int kk = 0; kk < 16; ++kk) {
            float av[4], bv[4], bv2[4];
#pragma unroll
            for (int i = 0; i < 4; ++i) av[i] = As[kk][ty * 4 + i];
#pragma unroll
            for (int j = 0; j < 4; ++j) { bv[j] = Ws[kk][tx * 4 + j]; if (EPI == EPI_GATEUP) bv2[j] = Ws2[kk][tx * 4 + j]; }
#pragma unroll
            for (int i = 0; i < 4; ++i)
#pragma unroll
                for (int j = 0; j < 4; ++j) { acc[i][j] += av[i] * bv[j]; if (EPI == EPI_GATEUP) acc2[i][j] += av[i] * bv2[j]; }
        }
        __syncthreads();
    }
#pragma unroll
    for (int i = 0; i < 4; ++i) { const int row = m0 + ty * 4 + i, b = row / S_;
#pragma unroll
        for (int j = 0; j < 4; ++j) { const int col = n0 + tx * 4 + j; if (col >= a.N) continue;
            float v = acc[i][j];
            if (EPI == EPI_RES) v = a.base[(size_t)row * a.ldc + col] + a.mod[b * NMOD + a.g_off + col] * v;
            if (EPI == EPI_GATEUP) { const float gq = v; v = gq / (1.f + expf(-gq)) * acc2[i][j]; }
            a.C[(size_t)row * a.ldc + col] = v; } }
}

__global__ void __launch_bounds__(192) nk_post_proj(float* proj, const int* positions, const float* bfg) {
    const int row = blockIdx.x, t = threadIdx.x; float* p = proj + (size_t)row * DIN;
    const int pos = positions[row];
    if (t < 168) { const int hh = t >> 3, i = t & 7;
        const int base = hh < 8 ? C_QD + hh * 64 : hh < 16 ? C_KD + (hh - 8) * 64 : hh < 20 ? C_IQ + (hh - 16) * 64 : C_IK;
        const float inv = (float)pow(500000.0, -(double)i / 8.0);
        const float angf = (float)pos * inv;
        const float c = (float)cos((double)angf), s = (float)sin((double)angf);
        const float x1 = p[base + i], x2 = p[base + 8 + i];
        p[base + i] = x1 * c - x2 * s; p[base + 8 + i] = x2 * c + x1 * s;
    } else if (t < 172) { p[C_IW + t - 168] *= 0.5f; }
    else if (t < 180) { const int h = t - 172; const float z = p[C_FG + h] + bfg[h]; p[C_FG + h] = fminf(z, 0.f) - log1pf(expf(-fabsf(z))); }
}

__global__ void __launch_bounds__(64) nk_cumsum(const float* proj, float* cum) {
    const int b = blockIdx.x >> 3, h = blockIdx.x & 7, l = threadIdx.x;
    const float* src = proj + (size_t)(b * S_ + 64 * l) * DIN + C_FG + h;
    double s = 0.0;
    for (int i = 0; i < 64; ++i) s += (double)src[(size_t)i * DIN];
    double incl = s;
    for (int o = 1; o < 64; o <<= 1) { const double v = __shfl_up(incl, o); if (l >= o) incl += v; }
    double run = incl - s;
    for (int i = 0; i < 64; ++i) { run += (double)src[(size_t)i * DIN]; cum[(size_t)(b * S_ + 64 * l + i) * 8 + h] = (float)run; }
}

__device__ __forceinline__ unsigned mono_key(float f) { const unsigned u = __float_as_uint(f); return (u & 0x80000000u) ? ~u : (u | 0x80000000u); }

__global__ void __launch_bounds__(256) nk_select(const float* proj, unsigned* mask) {
    __shared__ float iq[256]; __shared__ float iw[4]; __shared__ unsigned key[4096]; __shared__ unsigned hist[256]; __shared__ int sh_bin, sh_kk; __shared__ unsigned cnt[256]; __shared__ unsigned short half[256];
    const int t = blockIdx.x, b = blockIdx.y, tid = threadIdx.x, row = b * S_ + t, n = t + 1;
    unsigned* mrow = mask + (size_t)row * 128;
    if (n <= 256) { if (tid < 128) { const int lo = tid * 32; unsigned w = 0u; if (n >= lo + 32) w = 0xffffffffu; else if (n > lo) w = (1u << (n - lo)) - 1u; mrow[tid] = w; } return; }
    iq[tid] = proj[(size_t)row * DIN + C_IQ + tid]; if (tid < 4) iw[tid] = proj[(size_t)row * DIN + C_IW + tid];
    __syncthreads();
#pragma unroll 1
    for (int s = tid; s < n; s += 256) {
        asm volatile("" ::: "memory");
        const float4* kr = (const float4*)(proj + (size_t)(b * S_ + s) * DIN + C_IK);
        float d[4] = {0.f, 0.f, 0.f, 0.f};
#pragma unroll
        for (int j = 0; j < 16; ++j) { const float4 k4 = kr[j];
#pragma unroll
            for (int h = 0; h < 4; ++h) d[h] += iq[h * 64 + 4 * j] * k4.x + iq[h * 64 + 4 * j + 1] * k4.y + iq[h * 64 + 4 * j + 2] * k4.z + iq[h * 64 + 4 * j + 3] * k4.w; }
        float sc = 0.f;
#pragma unroll
        for (int h = 0; h < 4; ++h) sc += fmaxf(d[h] * 0.125f, 0.f) * iw[h];
        key[s] = mono_key(sc);
    }
    __syncthreads();
    unsigned prefix = 0u, pmask = 0u; int kk = 256;
    for (int shift = 24; shift >= 0; shift -= 8) {
        hist[tid] = 0u; __syncthreads();
        for (int s = tid; s < n; s += 256) { const unsigned k = key[s]; if ((k & pmask) == prefix) atomicAdd(&hist[(k >> shift) & 255u], 1u); }
        __syncthreads();
        if (tid == 0) { int c = 0, bin = 255; while (bin > 0 && c + (int)hist[bin] < kk) { c += (int)hist[bin]; --bin; } sh_bin = bin; sh_kk = kk - c; }
        __syncthreads();
        prefix |= (unsigned)sh_bin << shift; pmask |= 255u << shift; kk = sh_kk;
        __syncthreads();
    }
    unsigned ceq = 0u;
    for (int i = 0; i < 16; ++i) { const int s = tid * 16 + i; if (s < n && key[s] == prefix) ++ceq; }
    cnt[tid] = ceq; __syncthreads();
    unsigned before = 0u; for (int j = 0; j < tid; ++j) before += cnt[j];
    unsigned bits = 0u;
    for (int i = 0; i < 16; ++i) { const int s = tid * 16 + i; if (s < n) { const unsigned k = key[s];
        if (k > prefix) bits |= 1u << i; else if (k == prefix) { if ((int)before < kk) bits |= 1u << i; ++before; } } }
    half[tid] = (unsigned short)bits; __syncthreads();
    if (tid < 128) mrow[tid] = (unsigned)half[2 * tid] | ((unsigned)half[2 * tid + 1] << 16);
}

template <int MODE> __global__ void __launch_bounds__(256) nk_attn(const float* proj, int qoff, int koff, int voff, const float* cum, const unsigned* mask, float* o, int ooff) {
    __shared__ float lg[4096]; __shared__ float qs[64]; __shared__ float red[256];
    const int t = blockIdx.x, h = blockIdx.y, b = blockIdx.z, tid = threadIdx.x, row = b * S_ + t, n = t + 1;
    if (tid < 64) qs[tid] = proj[(size_t)row * DIN + qoff + h * 64 + tid];
    __syncthreads();
    const float cq = (MODE == 0) ? cum[(size_t)row * 8 + h] : 0.f;
    float mx = -INFINITY;
    for (int s = tid; s < n; s += 256) {
        const float4* kr = (const float4*)(proj + (size_t)(b * S_ + s) * DIN + koff + h * 64);
        float d = 0.f;
#pragma unroll
        for (int j = 0; j < 16; ++j) { const float4 k4 = kr[j]; d += qs[4 * j] * k4.x + qs[4 * j + 1] * k4.y + qs[4 * j + 2] * k4.z + qs[4 * j + 3] * k4.w; }
        d *= 0.125f;
        if (MODE == 0) d += cq - cum[(size_t)(b * S_ + s) * 8 + h];
        else { if (!((mask[(size_t)row * 128 + (s >> 5)] >> (s & 31)) & 1u)) d = -INFINITY; }
        lg[s] = d; mx = fmaxf(mx, d);
    }
    __syncthreads();
    mx = block_max256(mx, red);
    float sum = 0.f;
    for (int s = tid; s < n; s += 256) { const float p = expf(lg[s] - mx); lg[s] = p; sum += p; }
    __syncthreads();
    sum = block_sum256(sum, red);
    const int d = tid & 63, g = tid >> 6; float acc = 0.f;
    for (int s = g; s < n; s += 4) acc += lg[s] * proj[(size_t)(b * S_ + s) * DIN + voff + h * 64 + d];
    red[tid] = acc; __syncthreads();
    if (tid < 64) o[(size_t)row * D_ + ooff + h * 64 + tid] = (red[tid] + red[tid + 64] + red[tid + 128] + red[tid + 192]) / sum;
}

__global__ void __launch_bounds__(256) nk_group_norm(float* o, const float* gd, const float* gf) {
    __shared__ float red[256];
    const int row = blockIdx.x, tid = threadIdx.x, grp = tid >> 7, li = tid & 127;
    float4* p = (float4*)(o + (size_t)row * D_ + grp * 512) + li;
    const float4 v = *p;
    red[tid] = v.x * v.x + v.y * v.y + v.z * v.z + v.w * v.w; __syncthreads();
    for (int off = 64; off > 0; off >>= 1) { if (li < off) red[tid] += red[tid + off]; __syncthreads(); }
    const float rstd = 1.0f / sqrtf(red[grp * 128] * (1.0f / 512.f) + RMS_EPS);
    const float4 g = ((const float4*)(grp ? gf : gd))[li];
    *p = (float4){v.x * rstd * g.x, v.y * rstd * g.y, v.z * rstd * g.z, v.w * rstd * g.w};
}

namespace pg8 {
#define PG8_LAS __attribute__((address_space(3)))
typedef unsigned short bf16_t;
typedef _Float16 bf16x8 __attribute__((ext_vector_type(8)));
typedef float f32x4 __attribute__((ext_vector_type(4)));
typedef unsigned u32x4 __attribute__((ext_vector_type(4)));
constexpr int BM = 256, BK = 64, HALF = 128, HTB = HALF * BK * 2  , STAGE_BYTES = 8 * HTB, NXCD = 8, WGM = 8;

__host__ __device__ __forceinline__ int lds_byte(int r, int c) { const int st = (r >> 4) * 2 + (c >> 5), rr = r & 15, cc = c & 31, ob = rr * 64 + cc * 2; return st * 1024 + (ob ^ (((ob >> 9) & 1) << 5)); }
__host__ __device__ __forceinline__ void stage_rc(int b, int& R, int& C) { const int st = b / 1024, sb = b % 1024, swz = sb ^ (((sb >> 9) & 1) << 5); R = (st >> 1) * 16 + swz / 64; C = (st & 1) * 32 + (swz % 64) / 2; }
__host__ __device__ __forceinline__ int perm32(int rho) { const int n = rho >> 4, i = rho & 15; return 8 * (i >> 2) + 4 * n + (i & 3); }

struct Unit { int pm, pn; };
struct Gemm { const bf16_t* A; const bf16_t* Bt; int M, N, K; };

struct StaticOrder {
    int nM, nN, nwg, G, c;
    __host__ __device__ __forceinline__ void init(int M, int N, int G_, int c_) { nM = M / BM; nN = N / BM; nwg = nM * nN; G = G_; c = c_; }
    __host__ __device__ __forceinline__ bool next(int i, Unit& u) const {
        const long L = (long)i * G + c; if (L >= nwg) return false;
        int wgid = (int)L; { const int q = nwg / NXCD, r = nwg % NXCD, xcd = wgid % NXCD, off = wgid / NXCD; wgid = (xcd < r ? xcd * (q + 1) : r * (q + 1) + (xcd - r) * q) + off; }
        const int nig = WGM * nN, gid = wgid / nig, fm = gid * WGM, gsz = (nM - fm) < WGM ? (nM - fm) : WGM;
        u.pm = fm + ((wgid % nig) % gsz); u.pn = (wgid % nig) / gsz; return true;
    }
    __device__ __forceinline__ void a_ready(const Unit&) const {}
    __device__ __forceinline__ void done(const Unit&) const {}
};

__device__ __forceinline__ unsigned cvt_pk_f16(float lo, float hi) { typedef float f2_ __attribute__((ext_vector_type(2))); typedef _Float16 h2_ __attribute__((ext_vector_type(2))); f2_ v = {lo, hi}; h2_ h = __builtin_convertvector(v, h2_); return __builtin_bit_cast(unsigned, h); }
template <class Epi, class Sched, bool ALIGN_EPI = false, bool SP2 = false>
__device__ __forceinline__ void gemm_phase(PG8_LAS unsigned char* lds, const Gemm g, const Sched& S, const Epi& E) {
    const int tid = threadIdx.x, wid = __builtin_amdgcn_readfirstlane(tid >> 6), lane = tid & 63, wr = wid >> 2, wc = wid & 3, fr = lane & 15, fq = lane >> 4;
    const int K = g.K, nt = K / BK;
    unsigned voffA[2], voffB[2];
#pragma unroll
    for (int i = 0; i < 2; ++i) { int R, C; stage_rc(tid * 16 + i * 8192, R, C); const int Rb = Epi::PERM ? ((R & ~31) + perm32(R & 31)) : R;
        voffA[i] = (unsigned)(R * K + C) * 2u; voffB[i] = (unsigned)(Rb * K + C) * 2u; }
    const size_t kstep = (size_t)(BK * 2);
    const size_t hstep = (size_t)HALF * K * 2;
    const size_t tstep = 2 * hstep;
    const unsigned ldsw = (unsigned)wid * 1024u;
    const int aoff = lds_byte(wr * 64 + fr, fq * 8), boff = lds_byte(wc * 32 + fr, fq * 8);
#define PG8_SA(b, h) (((b) * 2 + (h)) * HTB)
#define PG8_SB(b, h) ((4 + (b) * 2 + (h)) * HTB)
#define PG8_STAGE(bufoff, gbase, voff) do { _Pragma("unroll") for (int _i = 0; _i < 2; ++_i) \
        __builtin_amdgcn_global_load_lds((const unsigned*)((const char*)(gbase) + (voff)[_i]), (PG8_LAS unsigned*)(lds + (bufoff) + ldsw + _i * 8192), 16, 0, 0); } while (0)
#define PG8_LDA(dst, b, h) do { _Pragma("unroll") for (int m = 0; m < 4; ++m) _Pragma("unroll") for (int k = 0; k < 2; ++k) dst[m][k] = *(const PG8_LAS bf16x8*)(lds + PG8_SA(b, h) + aoff + m * 2048 + k * 1024); } while (0)
#define PG8_LDB(dst, b, h) do { _Pragma("unroll") for (int n = 0; n < 2; ++n) _Pragma("unroll") for (int k = 0; k < 2; ++k) dst[n][k] = *(const PG8_LAS bf16x8*)(lds + PG8_SB(b, h) + boff + n * 2048 + k * 1024); } while (0)
#define PG8_MMA(ai, bj, At, Bt) do { __builtin_amdgcn_s_setprio(1); _Pragma("unroll") for (int m = 0; m < 4; ++m) _Pragma("unroll") for (int n = 0; n < 2; ++n) _Pragma("unroll") for (int k = 0; k < 2; ++k) \
        acc[ai][bj][m][n] = __builtin_amdgcn_mfma_f32_16x16x32_f16(Bt[n][k], At[m][k], acc[ai][bj][m][n], 0, 0, 0); __builtin_amdgcn_s_setprio(0); } while (0)
#define PG8_WAIT_V(n) asm volatile("s_waitcnt vmcnt(" #n ")" ::: "memory")
#define PG8_WAIT_L(n) asm volatile("s_waitcnt lgkmcnt(" #n ")" ::: "memory")
#define PG8_BAR __builtin_amdgcn_s_barrier()
#define PG8_SCHED __builtin_amdgcn_sched_barrier(0)
    Unit cur, nxt; int ui = 0;
    if (!S.next(0, cur)) return;
    f32x4 acc[2][2][4][2];
#pragma unroll
    for (int a = 0; a < 2; ++a)
#pragma unroll
        for (int b = 0; b < 2; ++b)
#pragma unroll
            for (int m = 0; m < 4; ++m)
#pragma unroll
                for (int n = 0; n < 2; ++n) acc[a][b][m][n] = (f32x4){0.f, 0.f, 0.f, 0.f};
    bf16x8 At[4][2], B0[2][2], B1[2][2];
    const char* cA = (const char*)g.A + (size_t)cur.pm * tstep; const char* cB = (const char*)g.Bt + (size_t)cur.pn * tstep;
    S.a_ready(cur);
    if constexpr (SP2) {
        PG8_STAGE(PG8_SB(0, 0), cB, voffB); PG8_STAGE(PG8_SB(0, 1), cB + hstep, voffB); PG8_STAGE(PG8_SA(0, 0), cA, voffA); PG8_STAGE(PG8_SA(0, 1), cA + hstep, voffA);
        if (wr == 1) PG8_BAR;
        PG8_WAIT_V(2); PG8_BAR;
        PG8_STAGE(PG8_SB(1, 0), cB + kstep, voffB); PG8_STAGE(PG8_SA(1, 0), cA + kstep, voffA); PG8_STAGE(PG8_SB(1, 1), cB + hstep + kstep, voffB);
        PG8_WAIT_V(6); PG8_BAR;
    } else {
        PG8_STAGE(PG8_SB(0, 0), cB, voffB); PG8_STAGE(PG8_SA(0, 0), cA, voffA); PG8_STAGE(PG8_SB(0, 1), cB + hstep, voffB); PG8_STAGE(PG8_SA(0, 1), cA + hstep, voffA);
        if (wr == 1) PG8_BAR;
        PG8_WAIT_V(4); PG8_BAR;
        PG8_STAGE(PG8_SB(1, 0), cB + kstep, voffB); PG8_STAGE(PG8_SA(1, 0), cA + kstep, voffA); PG8_STAGE(PG8_SB(1, 1), cB + hstep + kstep, voffB);
        PG8_WAIT_V(6); PG8_BAR;
    }
    for (;;) {
        const bool has_next = S.next(ui + 1, nxt);
        const char* nA = has_next ? (const char*)g.A + (size_t)nxt.pm * tstep : cA; const char* nB = has_next ? (const char*)g.Bt + (size_t)nxt.pn * tstep : cB;
        for (int t = 0; t < nt; t += 2) {
            const bool last = (t == nt - 2);
            if constexpr (Epi::HAS_MID) { if (t == nt / 2) E.mid(acc, cur, wr, wc, fr, fq); }
            const char* a1 = cA + (size_t)(t + 1) * kstep;
            const char* a2 = last ? nA : cA + (size_t)(t + 2) * kstep; const char* b2 = last ? nB : cB + (size_t)(t + 2) * kstep;
            const char* a3 = a2 + kstep; const char* b3 = b2 + kstep;
            if (last && has_next) S.a_ready(nxt);
            if constexpr (SP2) {
            PG8_LDB(B0, 0, 0); PG8_LDB(B1, 0, 1); PG8_SCHED; PG8_LDA(At, 0, 0); PG8_STAGE(PG8_SA(1, 1), a1 + hstep, voffA);
            PG8_WAIT_V(8); PG8_WAIT_L(0); PG8_BAR; PG8_MMA(0, 0, At, B0); PG8_MMA(0, 1, At, B1); PG8_BAR; PG8_SCHED;
            PG8_LDA(At, 0, 1); PG8_STAGE(PG8_SB(0, 0), b2, voffB); PG8_STAGE(PG8_SB(0, 1), b2 + hstep, voffB); PG8_STAGE(PG8_SA(0, 0), a2, voffA);
            PG8_WAIT_V(8); PG8_WAIT_L(0); PG8_BAR; PG8_MMA(1, 0, At, B0); PG8_MMA(1, 1, At, B1); PG8_BAR; PG8_SCHED;
            PG8_LDB(B0, 1, 0); PG8_LDB(B1, 1, 1); PG8_SCHED; PG8_LDA(At, 1, 0); PG8_STAGE(PG8_SA(0, 1), a2 + hstep, voffA);
            PG8_WAIT_V(8); PG8_WAIT_L(0); PG8_BAR; PG8_MMA(0, 0, At, B0); PG8_MMA(0, 1, At, B1); PG8_BAR; PG8_SCHED;
            PG8_LDA(At, 1, 1); PG8_STAGE(PG8_SB(1, 0), b3, voffB); PG8_STAGE(PG8_SB(1, 1), b3 + hstep, voffB); PG8_STAGE(PG8_SA(1, 0), a3, voffA);
            PG8_WAIT_V(8); PG8_WAIT_L(0); PG8_BAR; PG8_MMA(1, 0, At, B0); PG8_MMA(1, 1, At, B1); PG8_BAR; PG8_SCHED;
            } else {
            PG8_LDB(B0, 0, 0); PG8_SCHED; PG8_LDA(At, 0, 0); PG8_STAGE(PG8_SA(1, 1), a1 + hstep, voffA);
            PG8_WAIT_L(8); PG8_BAR; PG8_WAIT_L(0); PG8_MMA(0, 0, At, B0); PG8_BAR; PG8_SCHED;
            PG8_LDB(B1, 0, 1); PG8_STAGE(PG8_SB(0, 0), b2, voffB);
            PG8_BAR; PG8_WAIT_L(0); PG8_MMA(0, 1, At, B1); PG8_BAR;
            PG8_LDA(At, 0, 1); PG8_STAGE(PG8_SA(0, 0), a2, voffA);
            PG8_BAR; PG8_WAIT_L(0); PG8_MMA(1, 0, At, B0); PG8_BAR; PG8_SCHED;
            PG8_STAGE(PG8_SB(0, 1), b2 + hstep, voffB);
            PG8_WAIT_V(6); PG8_BAR; PG8_MMA(1, 1, At, B1); PG8_BAR;
            PG8_LDB(B0, 1, 0); PG8_SCHED; PG8_LDA(At, 1, 0); PG8_STAGE(PG8_SA(0, 1), a2 + hstep, voffA);
            PG8_WAIT_L(8); PG8_BAR; PG8_WAIT_L(0); PG8_MMA(0, 0, At, B0); PG8_BAR; PG8_SCHED;
            PG8_LDB(B1, 1, 1); PG8_STAGE(PG8_SB(1, 0), b3, voffB);
            PG8_BAR; PG8_WAIT_L(0); PG8_MMA(0, 1, At, B1); PG8_BAR;
            PG8_LDA(At, 1, 1); PG8_STAGE(PG8_SA(1, 0), a3, voffA);
            PG8_BAR; PG8_WAIT_L(0); PG8_MMA(1, 0, At, B0); PG8_BAR; PG8_SCHED;
            PG8_STAGE(PG8_SB(1, 1), b3 + hstep, voffB);
            PG8_WAIT_V(6); PG8_BAR; PG8_MMA(1, 1, At, B1); PG8_BAR;
            }
        }
        if constexpr (ALIGN_EPI) { if (wr == 0) PG8_BAR; }
        if constexpr (!Epi::AFTER_DRAIN) { E(acc, cur, wr, wc, fr, fq); S.done(cur); }
        if (!has_next) break;
#pragma unroll
        for (int a = 0; a < 2; ++a)
#pragma unroll
            for (int b = 0; b < 2; ++b)
#pragma unroll
                for (int m = 0; m < 4; ++m)
#pragma unroll
                    for (int n = 0; n < 2; ++n) acc[a][b][m][n] = (f32x4){0.f, 0.f, 0.f, 0.f};
        cur = nxt; cA = nA; cB = nB; ++ui;
        if constexpr (ALIGN_EPI) { if (wr == 1) PG8_BAR; }
    }
    PG8_WAIT_V(0);
    if constexpr (!ALIGN_EPI) { if (wr == 0) PG8_BAR; }
    PG8_BAR;
    if constexpr (Epi::AFTER_DRAIN) { E.fused(acc, cur, wr, wc, fr, fq, lds, wid, lane); S.done(cur); }
#undef PG8_SA
#undef PG8_SB
#undef PG8_STAGE
#undef PG8_LDA
#undef PG8_LDB
#undef PG8_MMA
#undef PG8_WAIT_V
#undef PG8_WAIT_L
#undef PG8_BAR
#undef PG8_SCHED
}
}
#define GAS __attribute__((address_space(1)))
#define LAS __attribute__((address_space(3)))
typedef _Float16 f16;
typedef unsigned v4u __attribute__((ext_vector_type(4)));
typedef unsigned v2u __attribute__((ext_vector_type(2)));
typedef float f32x4 __attribute__((ext_vector_type(4)));
typedef float f32x2 __attribute__((ext_vector_type(2)));
typedef GAS unsigned gu32;
typedef GAS unsigned long long gu64;
#define RLX_AGENT __ATOMIC_RELAXED, __HIP_MEMORY_SCOPE_AGENT
#define LDS_WAIT() asm volatile("s_waitcnt lgkmcnt(0)" ::: "memory")
#define VM_WAIT() asm volatile("s_waitcnt vmcnt(0)" ::: "memory")
__device__ __forceinline__ unsigned pkh(float lo, float hi) { typedef _Float16 h2_ __attribute__((ext_vector_type(2))); f32x2 v = {lo, hi}; h2_ h = __builtin_convertvector(v, h2_); return __builtin_bit_cast(unsigned, h); }
#define XB_TMO      128
#define XB_XCNT(j)  (256  + 64 * (j))
#define XB_XSUB(j)  (1280 + 64 * (j))
#define XB_XGEN(j)  (2304 + 64 * (j))
#define XB_TOP      3328
#define XB_TOPGEN   3392
#define XCD_BAR_WORDS 3456
#define XB_SPIN_CAP (1u << 18)

__device__ __forceinline__ unsigned xb_ld(unsigned* p)              { return __hip_atomic_load(p, __ATOMIC_RELAXED, __HIP_MEMORY_SCOPE_AGENT); }
__device__ __forceinline__ unsigned xb_add(unsigned* p, unsigned v) { return __hip_atomic_fetch_add(p, v, __ATOMIC_RELAXED, __HIP_MEMORY_SCOPE_AGENT); }
__device__ __forceinline__ unsigned xb_xcc_id() { return (unsigned)__builtin_amdgcn_s_getreg((3 << 11) | 20) & 0xFu; }
#define XB_SPIN(cond, bar) do { unsigned _sp = 0; while (cond) { __builtin_amdgcn_s_sleep(1); \
    if ((++_sp & 255u) == 0u) { if (xb_ld(&(bar)[XB_TMO])) break; if (_sp > XB_SPIN_CAP) { atomicAdd(&(bar)[XB_TMO], 1u); break; } } } } while (0)

struct XcdBarrier {
    unsigned* bar; unsigned x;
    volatile LAS unsigned* st;
};

__device__ __forceinline__ XcdBarrier xcd_barrier_post(unsigned* bar, volatile LAS unsigned* st) {
    XcdBarrier b; b.bar = bar; b.x = xb_xcc_id(); b.st = st;
    if (threadIdx.x == 0) (void)xb_add(&bar[XB_XCNT(b.x)], 1u);
    return b;
}
__device__ __forceinline__ void xcd_barrier_complete(unsigned* bar, unsigned x, unsigned& nloc, unsigned& nx) {
    const unsigned G = gridDim.x * gridDim.y * gridDim.z;
    unsigned sum, cnt, mine, sp = 0u;
    for (;;) {
        sum = 0u; cnt = 0u; mine = 0u;
#pragma unroll
        for (unsigned j = 0; j < 16; ++j) { const unsigned c = xb_ld(&bar[XB_XCNT(j)]); sum += c; cnt += (c > 0u) ? 1u : 0u; mine = (j == x) ? c : mine; }
        if (sum == G) break;
        __builtin_amdgcn_s_sleep(1);
        if ((++sp & 255u) == 0u) { if (xb_ld(&bar[XB_TMO])) break; if (sp > XB_SPIN_CAP) { atomicAdd(&bar[XB_TMO], 1u); break; } }
    }
    nloc = mine > 0u ? mine : 1u; nx = cnt > 0u ? cnt : 1u;
}

__device__ __forceinline__ void xcd_barrier(const XcdBarrier& b) {
    asm volatile("s_waitcnt vmcnt(0)" ::: "memory");
    __syncthreads();
    if (threadIdx.x == 0) {
        unsigned* bar = b.bar;
        __builtin_amdgcn_s_waitcnt(0);
        unsigned nloc = b.st[0], nx = b.st[1];
        if (nloc == 0u) { xcd_barrier_complete(bar, b.x, nloc, nx); b.st[0] = nloc; b.st[1] = nx; }
        const unsigned old = xb_add(&bar[XB_XSUB(b.x)], 1u);
        const unsigned gen = old / nloc;
        if (old + 1u == (gen + 1u) * nloc) {
            __builtin_amdgcn_fence(__ATOMIC_RELEASE, "agent");
            asm volatile("s_waitcnt vmcnt(0)" ::: "memory");
            const unsigned og = xb_add(&bar[XB_TOP], 1u);
            const unsigned tg = og / nx;
            if (og + 1u == (tg + 1u) * nx) xb_add(&bar[XB_TOPGEN], 1u);
            else XB_SPIN(xb_ld(&bar[XB_TOPGEN]) == tg, bar);
            __builtin_amdgcn_fence(__ATOMIC_ACQUIRE, "agent");
            xb_add(&bar[XB_XGEN(b.x)], 1u);
            asm volatile("s_waitcnt vmcnt(0)" ::: "memory");
        } else {
            XB_SPIN(xb_ld(&bar[XB_XGEN(b.x)]) == gen, bar);
            __builtin_amdgcn_fence(__ATOMIC_ACQUIRE, "agent");
            asm volatile("s_waitcnt vmcnt(0)" ::: "memory");
        }
    }
    __syncthreads();
}

namespace attn_body {
using bf16=_Float16;
using bf16x8=__attribute__((ext_vector_type(8)))_Float16;
using s16x4=__attribute__((ext_vector_type(4)))_Float16;
typedef float f32x4_t __attribute__((ext_vector_type(4)));
using f32x16=__attribute__((ext_vector_type(16)))float;
using u32x4=__attribute__((ext_vector_type(4)))unsigned;
constexpr int BATCH=8,NHEAD=8,SEQ=4096,D=64,DM=NHEAD*D,OPITCH=1024;
constexpr int NW=8,QBLK=32,QB=QBLK*NW,KVBLK=64,NQB=SEQ/QB;
constexpr int ATTN_PITCH=DM, ATTN_UNIT_ROWS=QB;
__device__ __forceinline__ int crow(int r,int hi){return (r&3)+8*(r>>2)+4*hi;}
#define SBAR() __builtin_amdgcn_sched_barrier(0)
__device__ __forceinline__ void cmask(f32x16&p0,f32x16&p1,int jb,int qrel,int hi){
  const float NEG=-INFINITY; int kb=64*jb+4*hi;
  #pragma unroll
  for(int r=0;r<16;++r){int kv=kb+(r&3)+8*(r>>2); if(kv>qrel)p0[r]=NEG; if(kv+32>qrel)p1[r]=NEG;}
}

constexpr int NSLOT=3, SLOTB=8192, LDS_MK=103424;
constexpr int LDS_K=0, LDS_V=NSLOT*SLOTB, LDS_WS=2*NSLOT*SLOTB, LDS_OST=LDS_WS+NW*64*4, LDS_BYTES=LDS_OST+NW*4096;
constexpr float C2=0.125f*1.4426950408889634f;
__device__ __forceinline__ void glds16(const void*gsrc,unsigned lds_dst){unsigned keep;
  asm volatile("s_mov_b32 %0, m0\n\ts_mov_b32 m0, %2\n\ts_nop 0\n\tglobal_load_lds_dwordx4 %1, off\n\ts_mov_b32 m0, %0":"=&s"(keep):"v"(gsrc),"s"(lds_dst):"memory");}
__device__ __forceinline__ void glds4(const void*gsrc,unsigned lds_dst){unsigned keep;
  asm volatile("s_mov_b32 %0, m0\n\ts_mov_b32 m0, %2\n\ts_nop 0\n\tglobal_load_lds_dword %1, off\n\ts_mov_b32 m0, %0":"=&s"(keep):"v"(gsrc),"s"(lds_dst):"memory");}
__device__ __forceinline__ float max3f(float a,float b,float c){float r;asm("v_max3_f32 %0, %1, %2, %3":"=v"(r):"v"(a),"v"(b),"v"(c));return r;}
__device__ __forceinline__ float max2f(float a,float b){float r;asm("v_max_f32_e32 %0, %1, %2":"=v"(r):"v"(a),"v"(b));return r;}
__device__ __forceinline__ float fadd_s(float a,float b){float r;asm("v_add_f32_e32 %0, %1, %2":"=v"(r):"v"(a),"v"(b));return r;}
__device__ __forceinline__ float fsub_s(float a,float b){float r;asm("v_sub_f32_e32 %0, %1, %2":"=v"(r):"v"(a),"v"(b));return r;}
typedef float f32x2_t __attribute__((ext_vector_type(2))); typedef _Float16 bf16x2_t __attribute__((ext_vector_type(2)));
__device__ __forceinline__ unsigned cvtpk_s(float lo,float hi){f32x2_t v={lo,hi};bf16x2_t b=__builtin_convertvector(v,bf16x2_t);return __builtin_bit_cast(unsigned,b);}
#define WAIT_BAR(N) asm volatile("s_waitcnt vmcnt(" #N ") lgkmcnt(0)\n\ts_barrier":::"memory")

__device__ __forceinline__ void qkt(f32x16&p0,f32x16&p1,const char*Kslot,const bf16x8*qr,const f32x16&negm,int r32,int hi){
  const char*kb=Kslot+hi*1024+r32*16;
  #pragma unroll
  for(int d0=0;d0<4;++d0){
    const bf16x8 b0=*reinterpret_cast<const bf16x8*>(kb+d0*2048);
    const bf16x8 b1=*reinterpret_cast<const bf16x8*>(kb+d0*2048+512);
    if(d0==0){p0=__builtin_amdgcn_mfma_f32_32x32x16_f16(b0,qr[0],negm,0,0,0);p1=__builtin_amdgcn_mfma_f32_32x32x16_f16(b1,qr[0],negm,0,0,0);}
    else{p0=__builtin_amdgcn_mfma_f32_32x32x16_f16(b0,qr[d0],p0,0,0,0);p1=__builtin_amdgcn_mfma_f32_32x32x16_f16(b1,qr[d0],p1,0,0,0);}}
}
typedef __attribute__((address_space(3))) const char* lds_cptr;
typedef short v4i16_t __attribute__((ext_vector_type(4)));
__device__ __forceinline__ void kload8(bf16x8*kf,lds_cptr kp){
  kf[0]=*(const __attribute__((address_space(3))) bf16x8*)(kp);      kf[1]=*(const __attribute__((address_space(3))) bf16x8*)(kp+512);
  kf[2]=*(const __attribute__((address_space(3))) bf16x8*)(kp+2048); kf[3]=*(const __attribute__((address_space(3))) bf16x8*)(kp+2560);
  kf[4]=*(const __attribute__((address_space(3))) bf16x8*)(kp+4096); kf[5]=*(const __attribute__((address_space(3))) bf16x8*)(kp+4608);
  kf[6]=*(const __attribute__((address_space(3))) bf16x8*)(kp+6144); kf[7]=*(const __attribute__((address_space(3))) bf16x8*)(kp+6656);
}
__device__ __forceinline__ void kload2(bf16x8*kf,lds_cptr kp,int j){ kf[2*j]=*(const __attribute__((address_space(3))) bf16x8*)(kp+j*2048); kf[2*j+1]=*(const __attribute__((address_space(3))) bf16x8*)(kp+j*2048+512); }
__device__ __forceinline__ s16x4 vtr(lds_cptr p){ return __builtin_bit_cast(s16x4,__builtin_amdgcn_ds_read_tr16_b64_v4i16((__attribute__((address_space(3))) v4i16_t*)p)); }
__device__ __forceinline__ float rowmax(const f32x16&p0,const f32x16&p1){
  float a=max3f(p0[0],p0[1],p1[0]),b=max3f(p0[2],p0[3],p1[1]);a=max3f(a,p1[2],p1[3]);
  #pragma unroll
  for(int r=4;r<16;r+=4){a=max3f(a,p0[r],p0[r+1]);b=max3f(b,p0[r+2],p0[r+3]);a=max3f(a,p1[r],p1[r+1]);b=max3f(b,p1[r+2],p1[r+3]);}
  const float m=max2f(a,b);
  auto rr=__builtin_amdgcn_permlane32_swap(__float_as_uint(m),__float_as_uint(m),false,false);
  return max2f(__uint_as_float(rr[0]),__uint_as_float(rr[1]));
}
__device__ __forceinline__ void pv(f32x16*o,int vb,bf16x8 pa0,bf16x8 pa1,bf16x8 pa2,bf16x8 pa3){
  #pragma unroll
  for(int d0=0;d0<2;++d0){s16x4 lo[4],hi[4];
    #pragma unroll
    for(int ks=0;ks<4;++ks){
      asm volatile("ds_read_b64_tr_b16 %0,%1 offset:%c2":"=&v"(lo[ks]):"v"(vb),"i"(d0*4096+ks*1024):"memory");
      asm volatile("ds_read_b64_tr_b16 %0,%1 offset:%c2":"=&v"(hi[ks]):"v"(vb),"i"(d0*4096+ks*1024+512):"memory");}
    asm volatile("s_waitcnt lgkmcnt(0)":::"memory");SBAR();
    #define PK(k) (bf16x8){lo[k][0],lo[k][1],lo[k][2],lo[k][3],hi[k][0],hi[k][1],hi[k][2],hi[k][3]}
    o[d0]=__builtin_amdgcn_mfma_f32_32x32x16_f16(pa0,PK(0),o[d0],0,0,0);
    o[d0]=__builtin_amdgcn_mfma_f32_32x32x16_f16(pa1,PK(1),o[d0],0,0,0);
    o[d0]=__builtin_amdgcn_mfma_f32_32x32x16_f16(pa2,PK(2),o[d0],0,0,0);
    o[d0]=__builtin_amdgcn_mfma_f32_32x32x16_f16(pa3,PK(3),o[d0],0,0,0);
    #undef PK
  }
}

#ifndef ATTN_STORE16
#define ATTN_STORE16(p,v) (*(u32x4*)(p)=(v))
#endif
typedef const __attribute__((address_space(3))) float* lds_cfptr;
template<int THRL,int MODE> __device__ __forceinline__ void attn_unit(int b,int h,int qb,const bf16*Q,const bf16*__restrict__ K,const bf16*__restrict__ V,bf16*O,float*ssq,int grp,lds_cfptr biasL,float qkmax,const unsigned*maskp,char*shm){
  int tid_=threadIdx.x; asm volatile("":"+v"(tid_));
  const int tid=tid_,lane=tid&63,r32=lane&31,hi=lane>>5; const int wid=__builtin_amdgcn_readfirstlane(tid>>6);
  const long rowbase=(long)b*SEQ; const int q0=qb*QB;
  const bf16*Qw=Q+(rowbase+q0+wid*QBLK)*DM+h*D;
  int ts=0; if(MODE==0){ const int ntf=(q0+QB)/KVBLK; const float lim=biasL[q0]-64.0f-qkmax; while(ts+2<=ntf-4 && biasL[64*(ts+2)-1]<lim) ts+=2; ts=__builtin_amdgcn_readfirstlane(ts); biasL+=64*ts; }
  const bf16*Kh=K+(rowbase+64*ts)*DM+h*D,*Vh=V+(rowbase+64*ts)*DM+h*D;
  const unsigned lds0=(unsigned)(uintptr_t)shm;
  float*wsf=(float*)(shm+LDS_WS)+wid*64;
  const bf16*ksrc=Kh+(long)lane*DM+wid*8;
  const bf16*vsrc=Vh+(long)(16*(wid&3)+(lane>>2))*DM+(wid>>2)*32+(lane&3)*8;
  const unsigned kdst=lds0+LDS_K+wid*1024, vdst=lds0+LDS_V+wid*1024;
  #define DMA_K(t,slot) glds16(ksrc+(long)(t)*KVBLK*DM,(unsigned)__builtin_amdgcn_readfirstlane(kdst+(slot)))
  #define DMA_V(t,slot) glds16(vsrc+(long)(t)*KVBLK*DM,(unsigned)__builtin_amdgcn_readfirstlane(vdst+(slot)))
  const int vb0=(int)(lds0+LDS_V)+((lane>>4)&1)*32+(lane&3)*8+(4*hi+((lane&15)>>2))*64;
  const char*Kbase=shm+LDS_K; bf16x8 kf[8];
  const lds_cptr shm3=(lds_cptr)shm; const lds_cptr kp0=shm3+LDS_K+hi*1024+r32*16; const lds_cptr vp0=shm3+LDS_V+((lane>>4)&1)*32+(lane&3)*8+(4*hi+((lane&15)>>2))*64;
  const int NT=(q0+QB)/KVBLK-ts;
  const int qrel=wid*QBLK+r32;
  unsigned mkA=0xffffffffu,mkB=0xffffffffu; const unsigned*mk_src=maskp+(rowbase+q0+qrel)*128+hi;
  const unsigned mk_lds=lds0+LDS_MK+wid*512; const __attribute__((address_space(3))) unsigned* mk_rd=(const __attribute__((address_space(3))) unsigned*)(shm3+LDS_MK+wid*512)+lane;
  #define MLOAD(t) do{ if(MODE==1){ glds4(mk_src+2*(t),(unsigned)__builtin_amdgcn_readfirstlane(mk_lds+(((t)&1)*256))); } }while(0)
  #define MREAD(MK,sl) do{ if(MODE==1){ MK=mk_rd[(sl)*64]; } }while(0)
  MLOAD(0); MLOAD(1);
  float bq=0.f; if(MODE==0) bq=biasL[q0+qrel-64*ts];
  DMA_K(0,0);DMA_V(0,0);DMA_K(1,SLOTB);
  bf16x8 qr[4];
  #pragma unroll
  for(int d0=0;d0<4;++d0)qr[d0]=*reinterpret_cast<const bf16x8*>(&Qw[(long)r32*DM+d0*16+hi*8]);
  float zf_; asm volatile("v_mov_b32 %0, 0":"=v"(zf_));
  float mhat=0.f,l_reg=0.f;f32x16 o[2];f32x16 negm;
  #pragma unroll
  for(int r=0;r<16;++r){o[0][r]=zf_;o[1][r]=zf_;negm[r]=zf_;}
  asm volatile("":"+v"(negm));
  #define CMASK(P0,P1,t) do{int jb_=(t)-(NT-4); if(jb_>=0)cmask(P0,P1,jb_,qrel,hi);}while(0)
  #define BIAS(P0,P1,t) do{ if(MODE==0){ const lds_cfptr bp_=biasL+(t)*64+4*hi; \
      _Pragma("unroll") for(int g_=0;g_<4;++g_){ const f32x4_t b0_=*(const __attribute__((address_space(3))) f32x4_t*)(bp_+8*g_), b1_=*(const __attribute__((address_space(3))) f32x4_t*)(bp_+32+8*g_); \
        _Pragma("unroll") for(int e_=0;e_<4;++e_){ P0[4*g_+e_]+=b0_[e_]; P1[4*g_+e_]+=b1_[e_]; } } } }while(0)
  #define MASKX(X,B,SH,MK) do{ if(MODE==1){ _Pragma("unroll") for(int i_=0;i_<4;++i_) X[(B)+i_]=__uint_as_float(__float_as_uint(X[(B)+i_])&(unsigned)__builtin_amdgcn_sbfe((int)(MK),(SH)+(B)+i_,1)); } }while(0)
  bool resc=false;
  #define START(P0,P1) do{ const float rm=(MODE==0)?bq:rowmax(P0,P1); resc=false; \
    { const float dl=rm; mhat=fadd_s(mhat,dl); \
      _Pragma("unroll") for(int r=0;r<16;++r){P0[r]=fsub_s(P0[r],dl);P1[r]=fsub_s(P1[r],dl);} \
      _Pragma("unroll") for(int r=0;r<16;++r)negm[r]=-mhat; asm volatile("":"+v"(negm)); } \
    _Pragma("unroll") for(int r=0;r<16;++r)P0[r]=__builtin_amdgcn_exp2f(P0[r]); \
    MASKX(P0,0,0,mkA);MASKX(P0,4,0,mkA);MASKX(P0,8,0,mkA);MASKX(P0,12,0,mkA); }while(0)
  #define RESC() do{ if(resc){ asm volatile("s_waitcnt lgkmcnt(0)":::"memory"); \
      _Pragma("unroll") for(int d_=0;d_<2;++d_) _Pragma("unroll") for(int r=0;r<16;++r)o[d_][r]*=wsf[crow(r,hi)]; } }while(0)
  f32x16 pA0,pA1,pB0,pB1;
  int sl_prev=0,sl_cur=0,sl_next=SLOTB;
  #define ROT() do{sl_prev=sl_cur;sl_cur=sl_next;sl_next=(sl_next==(NSLOT-1)*SLOTB)?0:sl_next+SLOTB;}while(0)
  DMA_K(2,2*SLOTB);
  WAIT_BAR(3); MREAD(mkA,0); MREAD(mkB,1);
  qkt(pA0,pA1,Kbase,qr,negm,r32,hi);asm volatile("s_nop 15\n\ts_nop 7":"+v"(pA0),"+v"(pA1));BIAS(pA0,pA1,0);CMASK(pA0,pA1,0);
  START(pA0,pA1);
  _Pragma("unroll") for(int r=0;r<16;++r)pA1[r]=__builtin_amdgcn_exp2f(pA1[r]);
  MASKX(pA1,0,16,mkA);MASKX(pA1,4,16,mkA);MASKX(pA1,8,16,mkA);MASKX(pA1,12,16,mkA);
  WAIT_BAR(0);
  DMA_K(3,0);DMA_V(1,SLOTB);
  ROT();
  kload8(kf,kp0+sl_cur);
  WAIT_BAR(2);
  s16x4 vlo[8],vhi[8]; u32x4 pw0,pw1,pw2,pw3;
  #define PKW(P,B) cvtpk_s(P[B],P[B+1])
  #define PAF(k) __builtin_bit_cast(bf16x8,pw##k)
  #define VFR(i) (bf16x8){vlo[i][0],vlo[i][1],vlo[i][2],vlo[i][3],vhi[i][0],vhi[i][1],vhi[i][2],vhi[i][3]}
  #define PIN(x) asm volatile("":"+v"(x))
  #define MX3(a,b,c) __builtin_fmaxf(__builtin_fmaxf((a),(b)),(c))
  #define GAPA(MF,A0,A1,A2,A3,W0,W1,PW) do{ MF; sacc+=A0; sacc+=A1; sacc+=A2; sacc+=A3; PIN(sacc); W0; W1; PIN(PW); SBAR(); }while(0)
  #define EX(v) __builtin_amdgcn_exp2f(v)
  #define GAPB(MF,X,B,SH) do{ MF; X[B]=EX(X[B]); X[B+1]=EX(X[B+1]); X[B+2]=EX(X[B+2]); X[B+3]=EX(X[B+3]); MASKX(X,B,SH,MKC_); PIN(X); SBAR(); }while(0)
  #define VRD(i) do{ vlo[i]=vtr(vp_+(((i)>>2)*4096+((i)&3)*1024)); vhi[i]=vtr(vp_+(((i)>>2)*4096+((i)&3)*1024+512)); }while(0)
  #define KRD(G,j) do{ if(G){ kload2(kf,kp0+sl_next,j); SBAR(); } }while(0)
  #define STEP(C0,C1,P0,P1,t,GK,GV,GL,MKC) do{ SBAR(); \
    const unsigned MKC_=(MKC); \
    const lds_cptr vp_=vp0+sl_prev; \
    VRD(0); SBAR(); float sacc=(P0[0]+P0[1]); \
    GAPA(C0=__builtin_amdgcn_mfma_f32_32x32x16_f16(kf[0],qr[0],negm,0,0,0), P0[2],P0[3],P0[4],P0[5],     pw0[0]=PKW(P0,0), pw0[1]=PKW(P0,2), pw0); \
    VRD(4); SBAR(); GAPA(C1=__builtin_amdgcn_mfma_f32_32x32x16_f16(kf[1],qr[0],negm,0,0,0), P0[6],P0[7],P0[8],P0[9],     pw0[2]=PKW(P0,4), pw0[3]=PKW(P0,6), pw0); \
    VRD(1); SBAR(); GAPA(C0=__builtin_amdgcn_mfma_f32_32x32x16_f16(kf[2],qr[1],C0,0,0,0),   P0[10],P0[11],P0[12],P0[13], pw1[0]=PKW(P0,8), pw1[1]=PKW(P0,10), pw1); \
    VRD(5); SBAR(); GAPA(C1=__builtin_amdgcn_mfma_f32_32x32x16_f16(kf[3],qr[1],C1,0,0,0),   P0[14],P0[15],P1[0],P1[1],   pw1[2]=PKW(P0,12),pw1[3]=PKW(P0,14), pw1); \
    VRD(2); SBAR(); GAPA(C0=__builtin_amdgcn_mfma_f32_32x32x16_f16(kf[4],qr[2],C0,0,0,0),   P1[2],P1[3],P1[4],P1[5],     pw2[0]=PKW(P1,0), pw2[1]=PKW(P1,2), pw2); \
    VRD(6); SBAR(); GAPA(C1=__builtin_amdgcn_mfma_f32_32x32x16_f16(kf[5],qr[2],C1,0,0,0),   P1[6],P1[7],P1[8],P1[9],     pw2[2]=PKW(P1,4), pw2[3]=PKW(P1,6), pw2); \
    VRD(3); SBAR(); GAPA(C0=__builtin_amdgcn_mfma_f32_32x32x16_f16(kf[6],qr[3],C0,0,0,0),   P1[10],P1[11],P1[12],P1[13], pw3[0]=PKW(P1,8), pw3[1]=PKW(P1,10), pw3); \
    VRD(7); SBAR(); GAPA(C1=__builtin_amdgcn_mfma_f32_32x32x16_f16(kf[7],qr[3],C1,0,0,0),   P1[14],P1[15],0.f,0.f,       pw3[2]=PKW(P1,12),pw3[3]=PKW(P1,14), pw3); \
    l_reg+=sacc; \
    if(GV){MLOAD((t)+1);} if(GK){DMA_K((t)+3,sl_cur);} if(GV){DMA_V((t)+1,sl_next);} \
    BIAS(C0,C1,t); CMASK(C0,C1,t); \
    { float a=MX3(C0[0],C0[1],C1[0]),b=MX3(C0[2],C0[3],C1[1]); a=MX3(a,C1[2],C1[3]); \
      _Pragma("unroll") for(int r=4;r<16;r+=4){a=MX3(a,C0[r],C0[r+1]);b=MX3(b,C0[r+2],C0[r+3]);a=MX3(a,C1[r],C1[r+1]);b=MX3(b,C1[r+2],C1[r+3]);} \
      float rm=__builtin_fmaxf(a,b); { auto rr=__builtin_amdgcn_permlane32_swap(__float_as_uint(rm),__float_as_uint(rm),false,false); rm=__builtin_fmaxf(__uint_as_float(rr[0]),__uint_as_float(rr[1])); } \
      resc=false; \
      if(__builtin_expect(__any(rm>(float)THRL),0)){ const float dl=__builtin_fmaxf(rm,0.f); mhat+=dl; \
        _Pragma("unroll") for(int r=0;r<16;++r){C0[r]-=dl;C1[r]-=dl;} \
        _Pragma("unroll") for(int r=0;r<16;++r)negm[r]=-mhat; asm volatile("":"+v"(negm)); \
        const float f=__builtin_amdgcn_exp2f(-dl); l_reg*=f; if(hi==0)wsf[r32]=f; resc=true; } } \
    SBAR(); \
    GAPB(o[0]=__builtin_amdgcn_mfma_f32_32x32x16_f16(PAF(0),VFR(0),o[0],0,0,0), C0,0,0); \
    GAPB(o[1]=__builtin_amdgcn_mfma_f32_32x32x16_f16(PAF(0),VFR(4),o[1],0,0,0), C0,4,0); \
    KRD(GL,0); GAPB(o[0]=__builtin_amdgcn_mfma_f32_32x32x16_f16(PAF(1),VFR(1),o[0],0,0,0), C0,8,0); \
    KRD(GL,1); GAPB(o[1]=__builtin_amdgcn_mfma_f32_32x32x16_f16(PAF(1),VFR(5),o[1],0,0,0), C0,12,0); \
    KRD(GL,2); GAPB(o[0]=__builtin_amdgcn_mfma_f32_32x32x16_f16(PAF(2),VFR(2),o[0],0,0,0), C1,0,16); \
    KRD(GL,3); GAPB(o[1]=__builtin_amdgcn_mfma_f32_32x32x16_f16(PAF(2),VFR(6),o[1],0,0,0), C1,4,16); \
    GAPB(o[0]=__builtin_amdgcn_mfma_f32_32x32x16_f16(PAF(3),VFR(3),o[0],0,0,0), C1,8,16); \
    GAPB(o[1]=__builtin_amdgcn_mfma_f32_32x32x16_f16(PAF(3),VFR(7),o[1],0,0,0), C1,12,16); \
    }while(0)
  int t=1;
  #undef CMASK
  #define CMASK(P0,P1,t) do{}while(0)
  for(;t+5<NT;t+=2){
    STEP(pB0,pB1,pA0,pA1,t,true,true,true,mkB);     WAIT_BAR(2); MREAD(mkA,0); RESC(); ROT();
    STEP(pA0,pA1,pB0,pB1,t+1,true,true,true,mkA);   WAIT_BAR(2); MREAD(mkB,1); RESC(); ROT();
  }
  #undef CMASK
  #define CMASK(P0,P1,t) do{int jb_=(t)-(NT-4); if(jb_>=0)cmask(P0,P1,jb_,qrel,hi);}while(0)
  #define ENDW(tt) do{ if((tt)+3<NT){WAIT_BAR(2);} else if((tt)+2<NT){WAIT_BAR(1);} else {WAIT_BAR(0);} }while(0)
  for(;t+1<NT;t+=2){
    STEP(pB0,pB1,pA0,pA1,t,(t+3<NT),(t+1<NT),(t+1<NT),mkB);       ENDW(t);   MREAD(mkA,0); RESC(); ROT();
    STEP(pA0,pA1,pB0,pB1,t+1,(t+4<NT),(t+2<NT),(t+2<NT),mkA);     ENDW(t+1); MREAD(mkB,1); RESC(); ROT();
  }
  STEP(pB0,pB1,pA0,pA1,NT-1,false,false,false,mkB); RESC();
  { float sacc=pB0[0]+pB0[1]; _Pragma("unroll") for(int r=2;r<16;++r)sacc+=pB0[r]; _Pragma("unroll") for(int r=0;r<16;++r)sacc+=pB1[r]; l_reg+=sacc;
    pw0=(u32x4){PKW(pB0,0),PKW(pB0,2),PKW(pB0,4),PKW(pB0,6)};pw1=(u32x4){PKW(pB0,8),PKW(pB0,10),PKW(pB0,12),PKW(pB0,14)};pw2=(u32x4){PKW(pB1,0),PKW(pB1,2),PKW(pB1,4),PKW(pB1,6)};pw3=(u32x4){PKW(pB1,8),PKW(pB1,10),PKW(pB1,12),PKW(pB1,14)};
    SBAR(); pv(o,vb0+sl_cur,PAF(0),PAF(1),PAF(2),PAF(3)); }
  #undef PKW
  #undef PAF
  #undef VFR
  #undef PIN
  #undef MX3
  #undef GAPA
  #undef GAPB
  #undef EX
  #undef VRD
  #undef KRD
  #undef STEP
  #undef ENDW
  {auto rr=__builtin_amdgcn_permlane32_swap(__float_as_uint(l_reg),__float_as_uint(l_reg),false,false);l_reg=__uint_as_float(rr[0])+__uint_as_float(rr[1]);}
  if(hi==0)wsf[32+r32]=l_reg;asm volatile("s_waitcnt lgkmcnt(0)":::"memory");
  float rli[16];
  #pragma unroll
  for(int r=0;r<16;++r)rli[r]=__builtin_amdgcn_rcpf(wsf[32+crow(r,hi)]);
  bf16*Ow=O+(rowbase+q0+wid*QBLK)*OPITCH+grp*512+h*D; float*sq=ssq+(size_t)(grp*8+h)*((size_t)BATCH*SEQ)+(rowbase+q0+wid*QBLK);
  { bf16*stg=(bf16*)(shm+LDS_OST)+wid*2048;
    #pragma unroll
    for(int r=0;r<16;++r){const int orow=crow(r,hi);
      #pragma unroll
      for(int d0=0;d0<2;++d0)stg[orow*64+d0*32+r32]=(bf16)(o[d0][r]*rli[r]);}
    asm volatile("s_waitcnt lgkmcnt(0)":::"memory");
    #pragma unroll
    for(int i=0;i<4;++i){const int row=i*8+(lane>>3),ch=lane&7; const u32x4 v=*(const u32x4*)(stg+row*64+ch*8); ATTN_STORE16(Ow+(long)row*OPITCH+ch*8,v);
      float s2=0.f;
      #pragma unroll
      for(int e=0;e<4;++e){const unsigned we=v[e]; const bf16x2_t hv=__builtin_bit_cast(bf16x2_t,we); const float a0=(float)hv[0],a1=(float)hv[1]; s2+=a0*a0+a1*a1;}
      s2+=__shfl_xor(s2,1); s2+=__shfl_xor(s2,2); s2+=__shfl_xor(s2,4);
      if(ch==0)sq[row]=s2; } }
  asm volatile("s_waitcnt lgkmcnt(0)\n\ts_barrier":::"memory");
  #undef DMA_K
  #undef DMA_V
  #undef CMASK
  #undef START
  #undef RESC
  #undef ROT
}
constexpr int ATTN_LDS_BYTES=LDS_BYTES;
#undef SBAR
#undef WAIT_BAR
}
namespace sel {
constexpr int NTHR = 512;
typedef _Float16 h8 __attribute__((ext_vector_type(8)));
typedef float f32x16 __attribute__((ext_vector_type(16)));
constexpr int NB = 512, HSTR = 513, CAP = 256, NSLOT3 = 3;
constexpr int L_HIST = 0, L_CAND = 0, L_KEY = 0, R_HIST = 49152, R_CNT = 50176, R_SEL = 52224, R_MISC = 56320;
constexpr int L_MASK = 65792, L_MASKE = L_MASK + 16384, L_T0 = L_MASKE + 16384, L_KK = L_T0 + 128, L_CNT = L_KK + 128, L_FLAG = L_CNT + 128, L_EQF = L_FLAG + 128, L_SLOT = L_EQF + 128, L_CJ = L_SLOT + 128, L_WH = L_CJ + 2048, L_WQ = L_WH + 8192, L_END = L_WQ + 128;
static_assert(32 * HSTR * 4 <= L_MASK && 32 * CAP * 8 <= L_MASK && R_MISC + 256 <= L_MASK && L_END <= 131072, "select LDS map");
__device__ __forceinline__ int crow(int r, int hi) { return (r & 3) + 8 * (r >> 2) + 4 * hi; }
__device__ __forceinline__ int bucket_of(float sc, float cq) { const float f = __builtin_fmaf(sc, cq, 256.0f); return (int)__builtin_amdgcn_fmed3f(f, 0.0f, 511.0f); }
__device__ __forceinline__ unsigned mono_key32(float f) { const unsigned u = __float_as_uint(f); return (u & 0x80000000u) ? ~u : (u | 0x80000000u); }
__device__ __forceinline__ void idx_to_hwbit(int s, int& hw, int& bit) { const int jt = s >> 5, w = s & 31, h2 = (w >> 2) & 1; bit = (w & 3) | ((w >> 3) << 2); hw = (((jt >> 1) * 2 + h2) * 2 + (jt & 1)); }

__device__ __forceinline__ void radix_row(LAS unsigned* key, int n, LAS unsigned char* rs, LAS unsigned short* mrow, int tid) {
    LAS unsigned* hist = (LAS unsigned*)(rs + R_HIST); LAS unsigned* cnt = (LAS unsigned*)(rs + R_CNT); LAS unsigned char* selb = (LAS unsigned char*)(rs + R_SEL); LAS int* misc = (LAS int*)(rs + R_MISC);
    unsigned prefix = 0u, pmask = 0u; int kk = 256;
    for (int shift = 24; shift >= 0; shift -= 8) {
        __syncthreads();
        if (tid < 256) hist[tid] = 0u;
        __syncthreads();
        for (int s = tid; s < n; s += NTHR) { const unsigned k = key[s]; if ((k & pmask) == prefix) __hip_atomic_fetch_add(&hist[(k >> shift) & 255u], 1u, __ATOMIC_RELAXED, __HIP_MEMORY_SCOPE_WORKGROUP); }
        __syncthreads();
        if (tid < 256) { unsigned above = 0u; for (int b2 = tid + 1; b2 < 256; ++b2) above += hist[b2]; const unsigned mine = hist[tid];
            if ((int)above < kk && (int)(above + mine) >= kk) { misc[0] = tid; misc[1] = kk - (int)above; } }
        __syncthreads();
        prefix |= (unsigned)misc[0] << shift; pmask |= 255u << shift; kk = misc[1];
    }
    unsigned ceq = 0u;
    for (int i = 0; i < 8; ++i) { const int s = tid * 8 + i; if (s < n && key[s] == prefix) ++ceq; }
    cnt[tid] = ceq; __syncthreads();
    unsigned before = 0u; for (int j = 0; j < tid; ++j) before += cnt[j];
    for (int i = 0; i < 8; ++i) { const int s = tid * 8 + i; unsigned char v = 0; if (s < n) { const unsigned k = key[s];
        if (k > prefix) v = 1; else if (k == prefix) { if ((int)before < kk) v = 1; ++before; } } selb[s] = v; }
    __syncthreads();
    if (tid < 256) { const int hw = tid, J = hw >> 2, hi = (hw >> 1) & 1, j = 2 * J + (hw & 1); unsigned bits = 0u;
        for (int r = 0; r < 16; ++r) { if (selb[32 * j + crow(r, hi)]) bits |= 1u << r; }
        mrow[hw] = (unsigned short)bits; }
    __syncthreads();
}

template <int PASS> __device__ __forceinline__ void score_pass(const f16* ikb, int b, int qt, int wave, int lane, const h8 (&bq)[4][4], float w0, float w1, float w2, float w3, float cq,
                                                               LAS unsigned* r0, LAS unsigned short* maskL, LAS unsigned short* maskE, LAS unsigned* ccnt, LAS unsigned* eqf, int T0, int slot) {
    const int ql = lane & 31, hi = lane >> 5;
    const f16* kbase = ikb + ((size_t)b * S_ + ql) * 64 + 8 * hi;
    h8 a[4], an[4];
#pragma unroll
    for (int ks = 0; ks < 4; ++ks) a[ks] = *(const h8*)(kbase + (size_t)(32 * wave) * 64 + 16 * ks);
    for (int kt = wave; kt <= qt; kt += 8) {
        const bool more = (kt + 8 <= qt);
        if (more) {
#pragma unroll
            for (int ks = 0; ks < 4; ++ks) an[ks] = *(const h8*)(kbase + (size_t)(32 * (kt + 8)) * 64 + 16 * ks); }
        f32x16 acc[4];
#pragma unroll
        for (int h = 0; h < 4; ++h) { acc[h] = __builtin_amdgcn_mfma_f32_32x32x16_f16(a[0], bq[h][0], (f32x16){0.f}, 0, 0, 0);
#pragma unroll
            for (int ks = 1; ks < 4; ++ks) acc[h] = __builtin_amdgcn_mfma_f32_32x32x16_f16(a[ks], bq[h][ks], acc[h], 0, 0, 0); }
        const bool diag = (kt == qt);
        unsigned bits = 0u, ebits = 0u;
#pragma unroll
        for (int r = 0; r < 16; ++r) {
            float sc = fmaxf(acc[0][r], 0.f) * w0; sc = __builtin_fmaf(fmaxf(acc[1][r], 0.f), w1, sc); sc = __builtin_fmaf(fmaxf(acc[2][r], 0.f), w2, sc); sc = __builtin_fmaf(fmaxf(acc[3][r], 0.f), w3, sc);
            const bool valid = !diag || (crow(r, hi) <= ql);
            if (PASS == 3) { if (slot >= 0) r0[slot * 4096 + 32 * kt + crow(r, hi)] = valid ? mono_key32(sc) : 0u; }
            else {
                const int bk = bucket_of(sc, cq);
                if (PASS == 1) { if (valid) __hip_atomic_fetch_add(r0 + ql * HSTR + bk, 1u, __ATOMIC_RELAXED, __HIP_MEMORY_SCOPE_WORKGROUP); }
                else {
                    if (valid && bk > T0) bits |= 1u << r;
                    if (valid && bk == T0) { if (sc == 0.0f) ebits |= 1u << r; else { const unsigned sl = __hip_atomic_fetch_add(ccnt + ql, 1u, __ATOMIC_RELAXED, __HIP_MEMORY_SCOPE_WORKGROUP);
                        if (sl < (unsigned)CAP) { r0[(ql * CAP + sl) * 2] = mono_key32(sc); r0[(ql * CAP + sl) * 2 + 1] = (unsigned)(32 * kt + crow(r, hi)); } } }
                }
            }
        }
        if (PASS == 2) { const int hwi = ql * 256 + (((kt >> 1) * 2 + hi) * 2 + (kt & 1)); maskL[hwi] = (unsigned short)bits; if (ebits) { maskE[hwi] = (unsigned short)ebits; eqf[ql] = 1u; } }
        if (more) {
#pragma unroll
            for (int ks = 0; ks < 4; ++ks) a[ks] = an[ks]; }
    }
}

__device__ __forceinline__ void select_unit(const f16* iqb, const f16* ikb, const float* iwb, unsigned short* mask, int b, int qt, LAS unsigned char* lds, int wave, LAS unsigned* tsl) {
#ifdef TPROBE
#define STS0(v) unsigned long long v = __builtin_amdgcn_s_memrealtime()
#define STS1(slot, v) do { if (threadIdx.x == 0) tsl[slot] += (unsigned)(__builtin_amdgcn_s_memrealtime() - (v)); } while (0)
#else
#define STS0(v) do {} while (0)
#define STS1(slot, v) do {} while (0)
#endif
    (void)tsl;
    int tid = threadIdx.x; asm volatile("" : "+v"(tid)); const int lane = tid & 63;
    const int t0 = 32 * qt;
    LAS unsigned* r0 = (LAS unsigned*)(lds + L_HIST); LAS unsigned short* maskL = (LAS unsigned short*)(lds + L_MASK); LAS unsigned short* maskE = (LAS unsigned short*)(lds + L_MASKE);
    LAS int* T0s = (LAS int*)(lds + L_T0); LAS int* KKs = (LAS int*)(lds + L_KK); LAS unsigned* ccnt = (LAS unsigned*)(lds + L_CNT); LAS unsigned* flag = (LAS unsigned*)(lds + L_FLAG);
    LAS unsigned* eqf = (LAS unsigned*)(lds + L_EQF); LAS int* slotm = (LAS int*)(lds + L_SLOT); LAS unsigned* wq = (LAS unsigned*)(lds + L_WQ); LAS unsigned* cj = (LAS unsigned*)(lds + L_CJ);
    __syncthreads();
    if (qt < 8) {
        for (int e = tid; e < 32 * 256; e += NTHR) { const int q = e >> 8, hw = e & 255, J = hw >> 2, hi = (hw >> 1) & 1, j = 2 * J + (hw & 1), t = t0 + q; unsigned bits = 0u;
#pragma unroll
            for (int r = 0; r < 16; ++r) if (32 * j + crow(r, hi) <= t) bits |= 1u << r;
            maskL[e] = (unsigned short)bits; }
    } else {
        for (int e = tid; e < 32 * HSTR; e += NTHR) r0[e] = 0u;
        for (int e = tid; e < 2 * 32 * 128; e += NTHR) ((LAS unsigned*)maskL)[e] = 0u;
        if (tid < 32) { ccnt[tid] = 0u; flag[tid] = 0u; eqf[tid] = 0u; } if (tid == 0) *wq = 0u;
        const int ql = lane & 31, hi = lane >> 5; const size_t qrow = (size_t)b * S_ + t0 + ql;
        h8 bq[4][4];
#pragma unroll
        for (int h = 0; h < 4; ++h)
#pragma unroll
            for (int ks = 0; ks < 4; ++ks) bq[h][ks] = *(const h8*)(iqb + qrow * 256 + h * 64 + 16 * ks + 8 * hi);
        const f32x4 wv = *(const f32x4*)(iwb + qrow * 4); const float w0 = wv.x * 0.125f, w1 = wv.y * 0.125f, w2 = wv.z * 0.125f, w3 = wv.w * 0.125f;
        const float cq = 65.0f / fmaxf(sqrtf((wv.x * wv.x + wv.y * wv.y) + (wv.z * wv.z + wv.w * wv.w)), 1e-30f);
        __syncthreads();
        STS0(s1_);
        score_pass<1>(ikb, b, qt, wave, lane, bq, w0, w1, w2, w3, cq, r0, maskL, maskE, ccnt, eqf, 0, -1);
        __syncthreads();
        STS1(16, s1_); STS0(s2_);
        { const int q = tid >> 4, j = tid & 15; unsigned c = 0u;
          for (int i = 0; i < 32; ++i) c += r0[q * HSTR + 32 * j + ((i + 2 * j) & 31)];
          cj[q * 16 + j] = c; }
        __syncthreads();
        { const int q = tid >> 4, j = tid & 15; unsigned above = 0u; for (int j2 = j + 1; j2 < 16; ++j2) above += cj[q * 16 + j2];
          const unsigned mine = cj[q * 16 + j];
          if (above < 256u && above + mine >= 256u) { int bk = 32 * j + 31; unsigned run = above;
              for (;; --bk) { const unsigned hc = r0[q * HSTR + bk]; if (run + hc >= 256u) break; run += hc; }
              T0s[q] = bk; KKs[q] = (int)(256u - run); } }
        __syncthreads();
        const int T0 = T0s[ql];
        STS1(17, s2_); STS0(s3_);
        score_pass<2>(ikb, b, qt, wave, lane, bq, w0, w1, w2, w3, cq, r0, maskL, maskE, ccnt, eqf, T0, -1);
        __syncthreads();
        STS1(18, s3_); STS0(s4_);
        LAS unsigned* wsc = cj + wave * 64;
        for (int it = 0; it < 32; ++it) { int q = 0; if (lane == 0) q = (int)__hip_atomic_fetch_add(wq, 1u, __ATOMIC_RELAXED, __HIP_MEMORY_SCOPE_WORKGROUP); q = __builtin_amdgcn_readfirstlane(q); if (q >= 32) break;
            const unsigned nc = ccnt[q]; const int kk = KKs[q];
            if (nc > (unsigned)CAP) { if (lane == 0) flag[q] = 1u; continue; }
            const bool haseq = eqf[q] != 0u;
            unsigned nz = 0u, before = 0u, wA = 0u, wB = 0u, cA = 0u, cB = 0u;
            if (haseq) {
                const unsigned e0 = ((LAS unsigned*)maskE)[q * 128 + 2 * lane], e1 = ((LAS unsigned*)maskE)[q * 128 + 2 * lane + 1];
#pragma unroll
                for (int g = 0; g < 4; ++g) { wA |= (((e0 >> (4 * g)) & 0xFu) << (8 * g)) | (((e1 >> (4 * g)) & 0xFu) << (8 * g + 4));
                                              wB |= (((e0 >> (16 + 4 * g)) & 0xFu) << (8 * g)) | (((e1 >> (16 + 4 * g)) & 0xFu) << (8 * g + 4)); }
                cA = __builtin_popcount(wA); cB = __builtin_popcount(wB);
                wsc[lane] = cA + cB;
                _Pragma("unroll 1") for (int l2 = 0; l2 < 64; ++l2) nz += wsc[l2];
                _Pragma("unroll 1") for (int l2 = 0; l2 < lane; ++l2) before += wsc[l2];
            }
            unsigned npos = 0u;
            for (unsigned c0 = 0; c0 < nc; c0 += 64) { const unsigned ci = c0 + lane; const bool pos = (ci < nc) && (r0[(q * CAP + ci) * 2] > 0x80000000u); npos += __builtin_popcountll(__ballot(pos)); }
            const int m = (kk <= (int)npos) ? kk : (((int)npos > kk - (int)nz) ? (int)npos : kk - (int)nz);
            if (nc <= 64u) {
                const bool have = (unsigned)lane < nc; unsigned myk = 0u, myi = 0u; if (have) { myk = r0[(q * CAP + lane) * 2]; myi = r0[(q * CAP + lane) * 2 + 1]; }
                unsigned rank = 0u;
                for (unsigned j = 0; j < nc; ++j) { const unsigned kj = r0[(q * CAP + j) * 2], ij = r0[(q * CAP + j) * 2 + 1]; rank += (kj > myk || (kj == myk && ij < myi)) ? 1u : 0u; }
                if (have && (int)rank < m) { int hw, bit; idx_to_hwbit((int)myi, hw, bit);
                    __hip_atomic_fetch_or((LAS unsigned*)maskL + q * 128 + (hw >> 1), 1u << (bit + 16 * (hw & 1)), __ATOMIC_RELAXED, __HIP_MEMORY_SCOPE_WORKGROUP); }
            } else if (m > 0) {
                LAS unsigned* wh = (LAS unsigned*)(lds + L_WH) + wave * 256;
                unsigned prefix = 0u, pmask = 0u; int mm = m;
                for (int shift = 24; shift >= 0; shift -= 8) {
#pragma unroll
                    for (int e = 0; e < 4; ++e) wh[lane + 64 * e] = 0u;
                    for (unsigned ci = lane; ci < nc; ci += 64) { const unsigned k = r0[(q * CAP + ci) * 2]; if ((k & pmask) == prefix) __hip_atomic_fetch_add(&wh[(k >> shift) & 255u], 1u, __ATOMIC_RELAXED, __HIP_MEMORY_SCOPE_WORKGROUP); }
                    const unsigned h0 = wh[4 * lane], h1 = wh[4 * lane + 1], h2 = wh[4 * lane + 2], h3 = wh[4 * lane + 3];
                    wsc[lane] = h0 + h1 + h2 + h3;
                    unsigned above = 0u; _Pragma("unroll 1") for (int l2 = lane + 1; l2 < 64; ++l2) above += wsc[l2];
                    int fb = -1, fm = 0;
                    { unsigned run = above; if ((int)run < mm && (int)(run + h3) >= mm) { fb = 4 * lane + 3; fm = mm - (int)run; } run += h3;
                      if (fb < 0 && (int)run < mm && (int)(run + h2) >= mm) { fb = 4 * lane + 2; fm = mm - (int)run; } run += h2;
                      if (fb < 0 && (int)run < mm && (int)(run + h1) >= mm) { fb = 4 * lane + 1; fm = mm - (int)run; } run += h1;
                      if (fb < 0 && (int)run < mm && (int)(run + h0) >= mm) { fb = 4 * lane; fm = mm - (int)run; } }
                    const unsigned long long bal = __ballot(fb >= 0); const int src = __builtin_ctzll(bal);
                    const int bin = __builtin_amdgcn_readlane(fb, src); mm = __builtin_amdgcn_readlane(fm, src);
                    prefix |= (unsigned)bin << shift; pmask |= 255u << shift;
                }
                for (unsigned c0 = 0; c0 < nc; c0 += 64) { const unsigned ci = c0 + lane; const bool have = ci < nc;
                    unsigned myk = 0u, myi = 0u; if (have) { myk = r0[(q * CAP + ci) * 2]; myi = r0[(q * CAP + ci) * 2 + 1]; }
                    bool take = have && myk > prefix;
                    const bool eq = have && myk == prefix;
                    if (__ballot(eq) != 0ull) { unsigned er = 0u; for (unsigned j = 0; j < nc; ++j) { const unsigned kj = r0[(q * CAP + j) * 2], ij = r0[(q * CAP + j) * 2 + 1]; er += (kj == prefix && ij < myi) ? 1u : 0u; }
                        take = take || (eq && (int)er < mm); }
                    if (take) { int hw, bit; idx_to_hwbit((int)myi, hw, bit);
                        __hip_atomic_fetch_or((LAS unsigned*)maskL + q * 128 + (hw >> 1), 1u << (bit + 16 * (hw & 1)), __ATOMIC_RELAXED, __HIP_MEMORY_SCOPE_WORKGROUP); } }
            }
            const int need = kk - (int)npos;
            if (haseq && nz != 0u && need > 0) {
                int mA = need - (int)before; mA = mA < 0 ? 0 : (mA > (int)cA ? (int)cA : mA);
                int mB = need - (int)before - (int)cA; mB = mB < 0 ? 0 : (mB > (int)cB ? (int)cB : mB);
                unsigned kA = 0u, kB = 0u, tA = wA, tB = wB;
                for (int m = 0; m < mA; ++m) { const unsigned lo = tA & (0u - tA); kA |= lo; tA ^= lo; }
                for (int m = 0; m < mB; ++m) { const unsigned lo = tB & (0u - tB); kB |= lo; tB ^= lo; }
                unsigned o0 = 0u, o1 = 0u;
#pragma unroll
                for (int g = 0; g < 4; ++g) { o0 |= (((kA >> (8 * g)) & 0xFu) << (4 * g)) | (((kB >> (8 * g)) & 0xFu) << (16 + 4 * g));
                                              o1 |= (((kA >> (8 * g + 4)) & 0xFu) << (4 * g)) | (((kB >> (8 * g + 4)) & 0xFu) << (16 + 4 * g)); }
                if (o0) __hip_atomic_fetch_or((LAS unsigned*)maskL + q * 128 + 2 * lane, o0, __ATOMIC_RELAXED, __HIP_MEMORY_SCOPE_WORKGROUP);
                if (o1) __hip_atomic_fetch_or((LAS unsigned*)maskL + q * 128 + 2 * lane + 1, o1, __ATOMIC_RELAXED, __HIP_MEMORY_SCOPE_WORKGROUP);
            }
        }
        __syncthreads();
        STS1(19, s4_); STS0(s5_);
        for (int qbase = 0; qbase < 32; ) {
            int nsl = 0, qnext = 32;
            __syncthreads();
            if (tid < 32) slotm[tid] = -1;
            __syncthreads();
            for (int q = qbase; q < 32; ++q) { if (flag[q] != 0u) { if (nsl == NSLOT3) { qnext = q; break; } if (tid == 0) slotm[q] = nsl; ++nsl; } }
            if (nsl == 0) break;
            __syncthreads();
            score_pass<3>(ikb, b, qt, wave, lane, bq, w0, w1, w2, w3, cq, r0, maskL, maskE, ccnt, eqf, 0, slotm[ql]);
            __syncthreads();
            for (int q = qbase; q < qnext; ++q) { const int sl = slotm[q]; if (sl >= 0) radix_row(r0 + sl * 4096, t0 + q + 1, lds, maskL + q * 256, tid); }
            qbase = qnext;
        }
        STS1(20, s5_);
    }
    __syncthreads();
    { const int q = tid >> 4, j = tid & 15; const LAS v4u* src = (const LAS v4u*)(maskL + q * 256) + 2 * j; GAS v4u* dst = (GAS v4u*)(mask + ((size_t)b * S_ + t0 + q) * 256) + 2 * j;
      dst[0] = src[0]; dst[1] = src[1]; }
}
}
constexpr int NWAVES = 8, NTHR = 512;
constexpr int NPROJ = 3584;
constexpr float C2 = 0.125f * 1.4426950408889634f;
constexpr int RING_BYTES = 131072, LDSCTL_OFF = RING_BYTES, MISC_OFF = LDSCTL_OFF + 320, LDS_BYTES = 147456;
constexpr int CW_TMO = 0, CW_CODE = 1, CW_BAR = 4096, CW_Q3 = 3008, CW_Q4 = 3072, CW_NRM = 3328;
constexpr int N_PHASES = 11;
constexpr size_t MiB = 1u << 20;

struct FArgs { const float* in[16]; float* out; unsigned* ctl; float* mod; float* rope;
    f16 *win_t, *wout_t, *wgu_t, *wd_t; float *iw, *logf; unsigned* mask; float* ssq;
    f16 *iq, *ik, *h, *o, *qd, *kd, *vd, *qf, *kf, *vf, *act; float *ssq2, *cb; int ph_lo, ph_hi, li, pad; };

__device__ __forceinline__ float wave_sum(float v) {
#pragma unroll
    for (int o = 1; o < 64; o <<= 1) v += __shfl_xor(v, o);
    return v;
}
__device__ __forceinline__ float fast_silu(float x) { return x * __builtin_amdgcn_rcpf(1.0f + __builtin_amdgcn_exp2f(-1.4426950408889634f * x)); }

__device__ __forceinline__ void tr_item(const float* W, int ldw, int K, int src_col0, f16* WT, int dst_row0, const float* kscale, LAS float* scr, int kb, int lane) {
    const int k0 = 64 * kb;
#pragma unroll 8
    for (int i = 0; i < 32; ++i) { const int kk = 2 * i + (lane >> 5); float v = W[(size_t)(k0 + kk) * ldw + src_col0 + (lane & 31)]; if (kscale) v *= kscale[k0 + kk]; scr[kk * 33 + (lane & 31)] = v; }
    LDS_WAIT(); asm volatile("" ::: "memory");
    const int c = lane & 7;
#pragma unroll
    for (int j = 0; j < 4; ++j) { const int n = (lane >> 3) + 8 * j; const LAS float* s = scr + (8 * c) * 33 + n;
        v4u o; o.x = pkh(s[0 * 33], s[1 * 33]); o.y = pkh(s[2 * 33], s[3 * 33]); o.z = pkh(s[4 * 33], s[5 * 33]); o.w = pkh(s[6 * 33], s[7 * 33]);
        *(GAS v4u*)(WT + (size_t)(dst_row0 + n) * K + k0 + 8 * c) = o; }
    LDS_WAIT(); asm volatile("" ::: "memory");
}

template <bool MODULATE, bool OUT_F16> __device__ __forceinline__ void norm_rows(const float* src, const float* g, const float* mod, int sh_off, int sc_off, f16* dst16, float* dst32, int gw, int ngw, int lane, float oscale = 1.0f) {
    for (int grp = gw; grp < M_ / 16; grp += ngw) {
        const int row0 = grp * 16, b = row0 / S_;
        f32x4 a[4], sh[4];
#pragma unroll
        for (int j = 0; j < 4; ++j) { a[j] = ((const f32x4*)g)[lane + 64 * j] * oscale;
            if (MODULATE) { const f32x4 sc = ((const f32x4*)(mod + b * NMOD + sc_off))[lane + 64 * j]; a[j] = a[j] * (sc + 1.0f); sh[j] = ((const f32x4*)(mod + b * NMOD + sh_off))[lane + 64 * j]; }
            else sh[j] = (f32x4){0.f, 0.f, 0.f, 0.f}; }
        for (int r = 0; r < 16; ++r) {
            const size_t roff = (size_t)(row0 + r) * D_;
            f32x4 v[4]; float ss = 0.f;
#pragma unroll
            for (int j = 0; j < 4; ++j) { v[j] = ((const GAS f32x4*)(src + roff))[lane + 64 * j]; ss += (v[j].x * v[j].x + v[j].y * v[j].y) + (v[j].z * v[j].z + v[j].w * v[j].w); }
            const float rstd = 1.0f / sqrtf(wave_sum(ss) * (1.0f / D_) + RMS_EPS);
#pragma unroll
            for (int j = 0; j < 4; ++j) { const f32x4 o = v[j] * rstd * a[j] + sh[j];
                if (OUT_F16) { v2u w; w.x = pkh(o.x, o.y); w.y = pkh(o.z, o.w); ((GAS v2u*)(dst16 + roff))[lane + 64 * j] = w; }
                else ((GAS f32x4*)(dst32 + roff))[lane + 64 * j] = o; }
        }
    }
}

struct EpiProj {
    static constexpr bool PERM = true, AFTER_DRAIN = false, HAS_MID = false;
    f16 *qd, *kd, *vd, *qf, *kf, *vf, *iq, *ik; float *iw, *logf; const float* rope; const float* bfg; unsigned* nrm;
    __device__ __forceinline__ void operator()(const f32x4 (&acc)[2][2][4][2], const pg8::Unit& u, int wr, int wc, int fr, int fq) const {
        const int pn = u.pn, row0 = u.pm * 256 + wr * 64 + fr;
        if (pn < 13) {
            f16* dst; int pitch = 512, colbase = (pn & 1) * 256; float scale = 1.f; bool rope_tile = false;
            if (pn < 12) { const int which = pn >> 1; dst = which == 0 ? qd : which == 1 ? kd : which == 2 ? vd : which == 3 ? qf : which == 4 ? kf : vf;
                if (which == 0 || which == 3) scale = C2; rope_tile = which < 2; }
            else { dst = iq; pitch = 256; colbase = 0; rope_tile = true; }
            const bool do_rope = rope_tile && ((wc & 1) == 0);
            const bool do_nrm = (pn >= 6 && pn < 10); float nmx[2] = {0.f, 0.f};
            const float sgn = (fq == 0) ? -1.f : 1.f;
#pragma unroll
            for (int ai = 0; ai < 2; ++ai)
#pragma unroll
                for (int m = 0; m < 4; ++m) { const int row = row0 + ai * 128 + m * 16;
                    f32x4 cs[4];
                    if (do_rope) {
#pragma unroll
                        for (int q = 0; q < 4; ++q) cs[q] = ((const f32x4*)(rope + (size_t)row * 16))[q]; }
#pragma unroll
                    for (int bj = 0; bj < 2; ++bj) { f32x4 v0 = acc[ai][bj][m][0], v1 = acc[ai][bj][m][1];
                        if (do_rope) {
                            f32x4 o0, o1;
#pragma unroll
                            for (int e = 0; e < 4; ++e) { o0[e] = __shfl_xor(v0[e], 16); o1[e] = __shfl_xor(v1[e], 16); }
                            if (fq < 2) {
                                v0[0] = v0[0] * cs[0][0] + sgn * o0[0] * cs[0][1]; v0[1] = v0[1] * cs[0][2] + sgn * o0[1] * cs[0][3];
                                v0[2] = v0[2] * cs[1][0] + sgn * o0[2] * cs[1][1]; v0[3] = v0[3] * cs[1][2] + sgn * o0[3] * cs[1][3];
                                v1[0] = v1[0] * cs[2][0] + sgn * o1[0] * cs[2][1]; v1[1] = v1[1] * cs[2][2] + sgn * o1[1] * cs[2][3];
                                v1[2] = v1[2] * cs[3][0] + sgn * o1[2] * cs[3][1]; v1[3] = v1[3] * cs[3][2] + sgn * o1[3] * cs[3][3]; }
                        }
                        v0 = v0 * scale; v1 = v1 * scale;
                        if (do_nrm) { float sq = (v0[0] * v0[0] + v0[1] * v0[1]) + (v0[2] * v0[2] + v0[3] * v0[3]) + (v1[0] * v1[0] + v1[1] * v1[1]) + (v1[2] * v1[2] + v1[3] * v1[3]); sq += __shfl_xor(sq, 16); sq += __shfl_xor(sq, 32); nmx[bj] = fmaxf(nmx[bj], sq); }
                        v4u w; w.x = pkh(v0[0], v0[1]); w.y = pkh(v0[2], v0[3]); w.z = pkh(v1[0], v1[1]); w.w = pkh(v1[2], v1[3]);
                        *(GAS v4u*)(dst + (size_t)row * pitch + colbase + bj * 128 + wc * 32 + 8 * fq) = w; } }
            if (do_nrm) {
#pragma unroll
                for (int bj = 0; bj < 2; ++bj) { float v = nmx[bj]; v = fmaxf(v, __shfl_xor(v, 1)); v = fmaxf(v, __shfl_xor(v, 2)); v = fmaxf(v, __shfl_xor(v, 4)); v = fmaxf(v, __shfl_xor(v, 8));
                    if ((fr | fq) == 0) __hip_atomic_fetch_max(nrm + (((u.pm * 256) / S_) * 8 + (pn & 1) * 4 + 2 * bj + (wc >> 1)) * 4 + (pn >= 8 ? 2 : 0) + (wc & 1), __float_as_uint(v), __ATOMIC_RELAXED, __HIP_MEMORY_SCOPE_AGENT); } }
        } else {
            const bool do_rope = (wc == 0);
            const float sgn = (fq == 0) ? -1.f : 1.f;
#pragma unroll
            for (int ai = 0; ai < 2; ++ai)
#pragma unroll
                for (int m = 0; m < 4; ++m) { const int row = row0 + ai * 128 + m * 16;
                    f32x4 v0 = acc[ai][0][m][0], v1 = acc[ai][0][m][1];
                    if (wc < 2) {
                        if (do_rope) {
                            f32x4 cs[4];
#pragma unroll
                            for (int q = 0; q < 4; ++q) cs[q] = ((const f32x4*)(rope + (size_t)row * 16))[q];
                            f32x4 o0, o1;
#pragma unroll
                            for (int e = 0; e < 4; ++e) { o0[e] = __shfl_xor(v0[e], 16); o1[e] = __shfl_xor(v1[e], 16); }
                            if (fq < 2) {
                                v0[0] = v0[0] * cs[0][0] + sgn * o0[0] * cs[0][1]; v0[1] = v0[1] * cs[0][2] + sgn * o0[1] * cs[0][3];
                                v0[2] = v0[2] * cs[1][0] + sgn * o0[2] * cs[1][1]; v0[3] = v0[3] * cs[1][2] + sgn * o0[3] * cs[1][3];
                                v1[0] = v1[0] * cs[2][0] + sgn * o1[0] * cs[2][1]; v1[1] = v1[1] * cs[2][2] + sgn * o1[1] * cs[2][3];
                                v1[2] = v1[2] * cs[3][0] + sgn * o1[2] * cs[3][1]; v1[3] = v1[3] * cs[3][2] + sgn * o1[3] * cs[3][3]; }
                        }
                        v4u w; w.x = pkh(v0[0], v0[1]); w.y = pkh(v0[2], v0[3]); w.z = pkh(v1[0], v1[1]); w.w = pkh(v1[2], v1[3]);
                        *(GAS v4u*)(ik + (size_t)row * 64 + wc * 32 + 8 * fq) = w;
                    } else if (wc == 2) {
                        if (fq == 0) { *(GAS f32x4*)(iw + (size_t)row * 4) = v0 * 0.5f; }
                        else if (fq == 1) {
                            const f32x4 b0 = ((const f32x4*)bfg)[0], b1 = ((const f32x4*)bfg)[1]; f32x4 z0 = v0 + b0, z1 = v1 + b1, l0, l1;
#pragma unroll
                            for (int e = 0; e < 4; ++e) { l0[e] = fminf(z0[e], 0.f) - log1pf(expf(-fabsf(z0[e]))); l1[e] = fminf(z1[e], 0.f) - log1pf(expf(-fabsf(z1[e]))); }
                            *(GAS f32x4*)(logf + (size_t)row * 8) = l0; *(GAS f32x4*)(logf + (size_t)row * 8 + 4) = l1; }
                    }
                }
        }
    }
};
struct EpiGateUp {
    static constexpr bool PERM = true, AFTER_DRAIN = false, HAS_MID = false; f16* act; const float* ssq2; const float* cb;
    __device__ __forceinline__ void operator()(const f32x4 (&acc)[2][2][4][2], const pg8::Unit& u, int wr, int wc, int fr, int fq) const {
        const int row0 = u.pm * 256 + wr * 64 + fr, col0 = u.pn * 128 + wc * 32 + 8 * fq, b = (u.pm * 256) / S_;
        const float* cbp = cb + (size_t)b * (2 * DFF) + u.pn * 256 + wc * 32 + 8 * fq;
        const f32x4 cg0 = *(const f32x4*)cbp, cg1 = *(const f32x4*)(cbp + 4), cu0 = *(const f32x4*)(cbp + 128), cu1 = *(const f32x4*)(cbp + 132);
#pragma unroll
        for (int ai = 0; ai < 2; ++ai)
#pragma unroll
            for (int m = 0; m < 4; ++m) { const int row = row0 + ai * 128 + m * 16; const float rs = 1.0f / sqrtf(ssq2[row] * (1.0f / D_) + RMS_EPS);
                const f32x4 g0 = acc[ai][0][m][0] * rs + cg0, g1 = acc[ai][0][m][1] * rs + cg1, u0 = acc[ai][1][m][0] * rs + cu0, u1 = acc[ai][1][m][1] * rs + cu1;
                v4u w; w.x = pkh(fast_silu(g0[0]) * u0[0], fast_silu(g0[1]) * u0[1]); w.y = pkh(fast_silu(g0[2]) * u0[2], fast_silu(g0[3]) * u0[3]);
                w.z = pkh(fast_silu(g1[0]) * u1[0], fast_silu(g1[1]) * u1[1]); w.w = pkh(fast_silu(g1[2]) * u1[2], fast_silu(g1[3]) * u1[3]);
                *(GAS v4u*)(act + (size_t)(row0 + ai * 128 + m * 16) * DFF + col0) = w; }
    }
};
struct EpiRes {
    static constexpr bool PERM = true, AFTER_DRAIN = false, HAS_MID = false; const float* base; float* out; const float* gvec;
    __device__ __forceinline__ void operator()(const f32x4 (&acc)[2][2][4][2], const pg8::Unit& u, int wr, int wc, int fr, int fq) const {
        const int row0 = u.pm * 256 + wr * 64 + fr, b = (u.pm * 256) / S_;
#pragma unroll
        for (int bj = 0; bj < 2; ++bj) { const int col = u.pn * 256 + bj * 128 + wc * 32 + 8 * fq;
            const f32x4 gv0 = *(const f32x4*)(gvec + b * NMOD + col), gv1 = *(const f32x4*)(gvec + b * NMOD + col + 4);
#pragma unroll
            for (int ai = 0; ai < 2; ++ai)
#pragma unroll
                for (int m = 0; m < 4; ++m) { const size_t off = (size_t)(row0 + ai * 128 + m * 16) * D_ + col;
                    const f32x4 x0 = *(const GAS f32x4*)(base + off), x1 = *(const GAS f32x4*)(base + off + 4);
                    *(GAS f32x4*)(out + off) = x0 + gv0 * acc[ai][bj][m][0]; *(GAS f32x4*)(out + off + 4) = x1 + gv1 * acc[ai][bj][m][1]; } }
    }
};

struct EpiOut {
    static constexpr bool PERM = true, AFTER_DRAIN = false, HAS_MID = true; const float* base; float* out; f16* ub; float* ssq2; const float* mod; const float* gffn; const LAS float* rs; int pm0;
    __device__ __forceinline__ void mid(f32x4 (&acc)[2][2][4][2], const pg8::Unit& u, int wr, int wc, int fr, int fq) const {
        const LAS float* t = rs + ((u.pm == pm0) ? 0 : 512) + (wr * 64 + fr) * 2;
#pragma unroll
        for (int ai = 0; ai < 2; ++ai)
#pragma unroll
            for (int m = 0; m < 4; ++m) { const LAS float* p = t + (ai * 128 + m * 16) * 2; const float ratio = p[0] / p[1];
#pragma unroll
                for (int bj = 0; bj < 2; ++bj) { acc[ai][bj][m][0] = acc[ai][bj][m][0] * ratio; acc[ai][bj][m][1] = acc[ai][bj][m][1] * ratio; } }
    }
    __device__ __forceinline__ void operator()(const f32x4 (&acc)[2][2][4][2], const pg8::Unit& u, int wr, int wc, int fr, int fq) const {
        const int row0 = u.pm * 256 + wr * 64 + fr, b = (u.pm * 256) / S_;
        const LAS float* t = rs + ((u.pm == pm0) ? 0 : 512) + (wr * 64 + fr) * 2;
        f32x4 gv[2][2], av[2][2];
#pragma unroll
        for (int bj = 0; bj < 2; ++bj) { const int col = u.pn * 256 + bj * 128 + wc * 32 + 8 * fq;
#pragma unroll
            for (int n = 0; n < 2; ++n) { gv[bj][n] = *(const f32x4*)(mod + b * NMOD + 2048 + col + 4 * n);
                av[bj][n] = *(const f32x4*)(gffn + col + 4 * n) * (*(const f32x4*)(mod + b * NMOD + 4096 + col + 4 * n) + 1.0f); } }
#pragma unroll
        for (int ai = 0; ai < 2; ++ai)
#pragma unroll
            for (int m = 0; m < 4; ++m) { const int row = row0 + ai * 128 + m * 16; const float rf = t[(ai * 128 + m * 16) * 2 + 1]; float sq = 0.f;
#pragma unroll
                for (int bj = 0; bj < 2; ++bj) { const size_t off = (size_t)row * D_ + u.pn * 256 + bj * 128 + wc * 32 + 8 * fq;
                    const f32x4 x0 = *(const GAS f32x4*)(base + off) + gv[bj][0] * (acc[ai][bj][m][0] * rf), x1 = *(const GAS f32x4*)(base + off + 4) + gv[bj][1] * (acc[ai][bj][m][1] * rf);
                    *(GAS f32x4*)(out + off) = x0; *(GAS f32x4*)(out + off + 4) = x1;
                    sq += (x0[0] * x0[0] + x0[1] * x0[1]) + (x0[2] * x0[2] + x0[3] * x0[3]) + (x1[0] * x1[0] + x1[1] * x1[1]) + (x1[2] * x1[2] + x1[3] * x1[3]);
                    const f32x4 y0 = x0 * av[bj][0], y1 = x1 * av[bj][1];
                    v4u w; w.x = pkh(y0[0], y0[1]); w.y = pkh(y0[2], y0[3]); w.z = pkh(y1[0], y1[1]); w.w = pkh(y1[2], y1[3]);
                    *(GAS v4u*)(ub + off) = w; }
                sq += __shfl_xor(sq, 16); sq += __shfl_xor(sq, 32);
                if (fq == 0) __hip_atomic_fetch_add(ssq2 + row, sq, __ATOMIC_RELAXED, __HIP_MEMORY_SCOPE_AGENT); }
    }
};

__global__ void __launch_bounds__(NTHR, 2) fwd(FArgs A0) {
    extern __shared__ __attribute__((aligned(16))) unsigned char lds_raw[];
    LAS unsigned char* lds = (LAS unsigned char*)lds_raw;
    volatile LAS unsigned* MISC = (volatile LAS unsigned*)(lds + MISC_OFF);
    const int tid0 = threadIdx.x, wave = __builtin_amdgcn_readfirstlane(tid0 >> 6);
#define PHASE_IDS int tid = threadIdx.x; asm volatile("" : "+v"(tid)); const int lane = tid & 63; (void)lane; \
    const __attribute__((address_space(4))) FArgs* Ap_ = (const __attribute__((address_space(4))) FArgs*)__builtin_amdgcn_kernarg_segment_ptr(); asm volatile("" : "+s"(Ap_)); const __attribute__((address_space(4))) FArgs& A = *Ap_;
    const int G = gridDim.x; const int bx = blockIdx.x; const int vcu = (G % 8 == 0) ? (bx % 8) * (G / 8) + bx / 8 : bx;
    const int gw = vcu * NWAVES + wave, NGW = G * NWAVES;
    for (int u = tid0; u < (LDS_BYTES - LDSCTL_OFF) / 4; u += NTHR) ((LAS unsigned*)(lds + LDSCTL_OFF))[u] = 0u;
    __syncthreads();
    XcdBarrier bar = xcd_barrier_post(A0.ctl + CW_BAR + A0.li * XCD_BAR_WORDS, MISC + 8);
    const int lo = A0.ph_lo, hi = A0.ph_hi;
#ifdef TPROBE
    LAS unsigned* tsl = (LAS unsigned*)(lds + LDSCTL_OFF + 64);
#define TS0(v) unsigned long long v = __builtin_amdgcn_s_memrealtime()
#define TS1(slot, v) do { if (threadIdx.x == 0) tsl[slot] += (unsigned)(__builtin_amdgcn_s_memrealtime() - (v)); } while (0)
#else
#define TS0(v) do {} while (0)
#define TS1(slot, v) do {} while (0)
#endif
#define IN(k) (lo <= (k) && (k) < hi)
#define NEXTP(k) (((k) == 4 || (k) == 6) ? (k) + 2 : (k) + 1)
#define BOTH(k) (IN(k) && IN(NEXTP(k)))
#define GRID_BAR() do { TS0(tb_); xcd_barrier(bar); TS1(10, tb_); } while (0)


    if (IN(0)) { PHASE_IDS TS0(tp_);
        LAS float* scr = (LAS float*)(lds + wave * 16384);
        constexpr int I_IN = 106 * 16, I_OUT = 32 * 16, I_G = 88 * 16, I_D = 32 * 44, NITEMS = I_IN + I_OUT + 2 * I_G + I_D;
        for (int it = gw; it < NITEMS; it += NGW) {
            int r = it;
            if (r < I_IN) { const int nb = r >> 4, kb = r & 15; int dst, src;
                if (nb < 48) { dst = 32 * nb; src = 32 * nb; } else if (nb < 96) { dst = 1536 + 32 * (nb - 48); src = C_QF + 32 * (nb - 48); }
                else if (nb < 104) { dst = 3072 + 32 * (nb - 96); src = C_IQ + 32 * (nb - 96); } else { dst = 3328 + 32 * (nb - 104); src = C_IK + 32 * (nb - 104); }
                tr_item(A.in[6], DIN, D_, src, A.win_t, dst, nullptr, scr, kb, lane); continue; } r -= I_IN;
            if (r < I_OUT) { const int nb = r >> 4, kb = r & 15; tr_item(A.in[10], D_, D_, 32 * nb, A.wout_t, 32 * nb, (A.pad & 1) ? nullptr : (kb < 8 ? A.in[8] : A.in[9] - 512), scr, kb, lane); continue; } r -= I_OUT;
            if (r < I_G) { const int nb = r >> 4, kb = r & 15; tr_item(A.in[12], DFF, D_, 32 * nb, A.wgu_t, 256 * (nb >> 2) + 32 * (nb & 3), nullptr, scr, kb, lane); continue; } r -= I_G;
            if (r < I_G) { const int nb = r >> 4, kb = r & 15; tr_item(A.in[13], DFF, D_, 32 * nb, A.wgu_t, 256 * (nb >> 2) + 128 + 32 * (nb & 3), nullptr, scr, kb, lane); continue; } r -= I_G;
            { const int nb = r / 44, kb = r % 44; tr_item(A.in[14], D_, DFF, 32 * nb, A.wd_t, 32 * nb, nullptr, scr, kb, lane); }
        }
        for (int e = vcu * NTHR + tid; e < 192 * D_; e += G * NTHR) { const int np = 64 + e / D_, k = e % D_;
            const int src = (np < 68) ? C_IW + np - 64 : (np >= 72 && np < 80) ? C_FG + np - 72 : -1;
            A.win_t[(size_t)(3328 + np) * D_ + k] = src >= 0 ? (f16)A.in[6][(size_t)k * DIN + src] : (f16)0.f; }
        for (int e = vcu * NTHR + tid; e < M_ * 8; e += G * NTHR) { const int row = e >> 3, i = e & 7;
            const float inv = (float)pow(500000.0, -(double)i / 8.0); const float angf = (float)((const int*)A.in[2])[row] * inv;
            A.rope[2 * e] = (float)cos((double)angf); A.rope[2 * e + 1] = (float)sin((double)angf); }
        __syncthreads();
        for (int slot = vcu; slot < NMOD / 32; slot += G) {
            LAS float* ca = (LAS float*)lds; LAS float* red = ca + 8192;
            for (int i = tid; i < 8192; i += NTHR) { const float v = A.in[1][i]; ca[i] = v / (1.f + expf(-v)); }
            __syncthreads();
            const int kg = tid >> 5, cc = tid & 31, n = slot * 32 + cc;
            float acc[8];
#pragma unroll
            for (int b = 0; b < 8; ++b) acc[b] = 0.f;
            for (int k = kg; k < D_; k += 16) { const float w = A.in[3][(size_t)k * NMOD + n];
#pragma unroll
                for (int b = 0; b < 8; ++b) acc[b] += ca[b * 1024 + k] * w; }
#pragma unroll
            for (int b = 0; b < 8; ++b) red[(kg * 8 + b) * 32 + cc] = acc[b];
            __syncthreads();
            if (tid < 256) { const int b = tid >> 5; float s = 0.f;
#pragma unroll
                for (int k2 = 0; k2 < 16; ++k2) s += red[(k2 * 8 + b) * 32 + cc];
                A.mod[b * NMOD + n] = s + A.in[4][n]; }
            __syncthreads();
        }
        TS1(0, tp_); if (BOTH(0)) GRID_BAR();
    }
    if (IN(1)) { PHASE_IDS TS0(tp_); norm_rows<true, true>(A.in[0], A.in[5], A.mod, 0, 1024, A.h, nullptr, gw, NGW, lane);
        for (int r = gw; r < 2 * DFF; r += NGW) { const f16* wp = A.wgu_t + (size_t)r * D_ + lane * 16; const sel::h8 wa = *(const sel::h8*)wp, wb = *(const sel::h8*)(wp + 8); float mine = 0.f;
#pragma unroll
            for (int b = 0; b < 8; ++b) { const float* sp = A.mod + b * NMOD + 3072 + lane * 16; const f32x4 s0 = *(const f32x4*)sp, s1 = *(const f32x4*)(sp + 4), s2 = *(const f32x4*)(sp + 8), s3 = *(const f32x4*)(sp + 12);
                float a = (float)wa[0] * s0[0] + (float)wa[1] * s0[1] + (float)wa[2] * s0[2] + (float)wa[3] * s0[3] + (float)wa[4] * s1[0] + (float)wa[5] * s1[1] + (float)wa[6] * s1[2] + (float)wa[7] * s1[3]
                        + (float)wb[0] * s2[0] + (float)wb[1] * s2[1] + (float)wb[2] * s2[2] + (float)wb[3] * s2[3] + (float)wb[4] * s3[0] + (float)wb[5] * s3[1] + (float)wb[6] * s3[2] + (float)wb[7] * s3[3];
                a = wave_sum(a); mine = (lane == b) ? a : mine; }
            if (lane < 8) A.cb[(size_t)lane * (2 * DFF) + r] = mine; }
        TS1(1, tp_); if (BOTH(1)) GRID_BAR(); }
    if (IN(2)) { PHASE_IDS TS0(tp_);
        pg8::Gemm g{(const pg8::bf16_t*)A.h, (const pg8::bf16_t*)A.win_t, M_, NPROJ, D_}; pg8::StaticOrder S; S.init(M_, NPROJ, G, bx);
        EpiProj E{A.qd, A.kd, A.vd, A.qf, A.kf, A.vf, A.iq, A.ik, A.iw, A.logf, A.rope, A.in[7], A.ctl + CW_NRM};
        pg8::gemm_phase<EpiProj, pg8::StaticOrder, true, true>(lds, g, S, E);
        TS1(2, tp_); if (BOTH(2)) GRID_BAR();
    }
    if (IN(3)) { PHASE_IDS TS0(tp_);
        (void)tid;
        for (int it = 0; it < 1024; ++it) {
            __syncthreads(); if (tid == 0) MISC[16] = __hip_atomic_fetch_add(A.ctl + CW_Q3, 1u, __ATOMIC_RELAXED, __HIP_MEMORY_SCOPE_AGENT); __syncthreads();
            const int idx = (int)MISC[16]; if (idx >= 1024) break; const int qt = 127 - (idx >> 3), sb = idx & 7;
            sel::select_unit(A.iq, A.ik, A.iw, (unsigned short*)A.mask, sb, qt, lds, wave, (LAS unsigned*)(lds + LDSCTL_OFF + 64)); }
        TS1(3, tp_); if (BOTH(3)) GRID_BAR();
    }
    if (IN(4)) { PHASE_IDS TS0(tp_);
        char* shm = (char*)lds_raw;
        TS0(tf_);
        LAS float* biasL = (LAS float*)(lds + 86016); LAS float* wtot = biasL + 4096; int cur_bh = -1; float qkmax = 0.f;
        for (int uid = vcu; uid < 1024; uid += G) { const int v = uid & 255, i = uid >> 8, bh = v >> 2, s4 = v & 3; const int qb = (i == 0) ? s4 : (i == 1) ? 7 - s4 : (i == 2) ? 8 + s4 : 15 - s4;
            if (bh != cur_bh) {
                cur_bh = bh; __syncthreads();
                int tl = threadIdx.x; asm volatile("" : "+v"(tl)); const int ln = tl & 63;
                const int base = tl * 8; float pv[8]; float run = 0.f;
#pragma unroll
                for (int e = 0; e < 8; ++e) { run += A.logf[(size_t)((bh >> 3) * S_ + base + e) * 8 + (bh & 7)]; pv[e] = run; }
                float incl = run;
#pragma unroll
                for (int o = 1; o < 64; o <<= 1) { const int src = ln - o; const float y = __int_as_float(__builtin_amdgcn_ds_bpermute((src < 0 ? ln : src) << 2, __float_as_int(incl))); if (ln >= o) incl += y; }
                if (ln == 63) wtot[wave] = incl;
                __syncthreads();
                float woff = 0.f; for (int w2 = 0; w2 < wave; ++w2) woff += wtot[w2];
                const float excl = woff + incl - run;
#pragma unroll
                for (int e = 0; e < 8; ++e) biasL[base + e] = -(excl + pv[e]) * 1.4426950408889634f;
                { const unsigned* np = A.ctl + CW_NRM + bh * 4;
                  const float n0 = __uint_as_float(__hip_atomic_load(np, __ATOMIC_RELAXED, __HIP_MEMORY_SCOPE_AGENT)), n1 = __uint_as_float(__hip_atomic_load(np + 1, __ATOMIC_RELAXED, __HIP_MEMORY_SCOPE_AGENT)),
                              n2 = __uint_as_float(__hip_atomic_load(np + 2, __ATOMIC_RELAXED, __HIP_MEMORY_SCOPE_AGENT)), n3 = __uint_as_float(__hip_atomic_load(np + 3, __ATOMIC_RELAXED, __HIP_MEMORY_SCOPE_AGENT));
                  qkmax = sqrtf(n0 + n1) * sqrtf(n2 + n3) * 1.002f; }
                __syncthreads();
            }
            attn_body::attn_unit<8, 0>(bh >> 3, bh & 7, qb, A.qf, A.kf, A.vf, A.o, A.ssq, 1, (attn_body::lds_cfptr)biasL, qkmax, nullptr, shm); }
        TS1(23, tf_); TS0(td_);
        for (int it = 0; it < 1024; ++it) {
            __syncthreads(); if (tid == 0) MISC[16] = __hip_atomic_fetch_add(A.ctl + CW_Q4, 1u, __ATOMIC_RELAXED, __HIP_MEMORY_SCOPE_AGENT); __syncthreads();
            const int idx = (int)MISC[16]; if (idx >= 1024) break; const int qb = 15 - (idx >> 6), bh = idx & 63;
            attn_body::attn_unit<8, 1>(bh >> 3, bh & 7, qb, A.qd, A.kd, A.vd, A.o, A.ssq, 0, nullptr, 0.f, A.mask, shm); }
        TS1(22, td_); TS1(4, tp_); if (BOTH(4)) GRID_BAR();
    }
    if (IN(6)) { PHASE_IDS TS0(tp_);
        pg8::Gemm g{(const pg8::bf16_t*)A.o, (const pg8::bf16_t*)A.wout_t, M_, D_, D_}; pg8::StaticOrder S; S.init(M_, D_, G, bx);
        LAS float* rs = (LAS float*)(lds + LDSCTL_OFF + 1024);
        pg8::Unit u0{0, 0}, u1{0, 0}; const bool two = S.next(0, u0) && S.next(1, u1); if (!two) u1 = u0;
        { const int slot = tid >> 8, r = tid & 255, row = (slot ? u1.pm : u0.pm) * 256 + r; float sd = 0.f, sf = 0.f;
#pragma unroll
          for (int hh = 0; hh < 8; ++hh) { sd += A.ssq[(size_t)hh * M_ + row]; sf += A.ssq[(size_t)(8 + hh) * M_ + row]; }
          rs[(slot * 256 + r) * 2] = 1.0f / sqrtf(sd * (1.0f / 512.f) + RMS_EPS); rs[(slot * 256 + r) * 2 + 1] = 1.0f / sqrtf(sf * (1.0f / 512.f) + RMS_EPS); }
        __syncthreads();
        EpiOut E{A.in[0], A.out, A.h, A.ssq2, A.mod, A.in[11], rs, u0.pm};
        pg8::gemm_phase<EpiOut, pg8::StaticOrder, true, true>(lds, g, S, E);
        TS1(6, tp_); if (BOTH(6)) GRID_BAR();
    }
    if (IN(8)) { PHASE_IDS TS0(tp_);
        pg8::Gemm g{(const pg8::bf16_t*)A.h, (const pg8::bf16_t*)A.wgu_t, M_, 2 * DFF, D_}; pg8::StaticOrder S; S.init(M_, 2 * DFF, G, bx);
        EpiGateUp E{A.act, A.ssq2, A.cb};
        pg8::gemm_phase<EpiGateUp, pg8::StaticOrder, true, true>(lds, g, S, E);
        TS1(8, tp_); if (BOTH(8)) GRID_BAR();
    }
    if (IN(9)) { PHASE_IDS TS0(tp_);
        pg8::Gemm g{(const pg8::bf16_t*)A.act, (const pg8::bf16_t*)A.wd_t, M_, D_, DFF}; pg8::StaticOrder S; S.init(M_, D_, G, bx);
        EpiRes E{A.out, A.out, A.mod + 5120};
        pg8::gemm_phase<EpiRes, pg8::StaticOrder, true, true>(lds, g, S, E);
        TS1(9, tp_);
#ifdef TPROBE
        __syncthreads(); if (threadIdx.x < 32) __hip_atomic_fetch_max(A.ctl + 2048 + threadIdx.x, tsl[threadIdx.x], __ATOMIC_RELAXED, __HIP_MEMORY_SCOPE_AGENT);
#endif
        if (BOTH(9)) GRID_BAR();
    }
    if (IN(10)) { PHASE_IDS
        float oscale = 1.0f;
#ifdef TPROBE
        oscale = 1.0f + sqrtf((float)__hip_atomic_load(A.ctl + 2048 + TPROBE, __ATOMIC_RELAXED, __HIP_MEMORY_SCOPE_AGENT) * 1e-2f * 1e-5f);
#endif
        norm_rows<false, false>(A.out, A.in[15], nullptr, 0, 0, nullptr, A.out, gw, NGW, lane, oscale); }
#undef IN
#undef BOTH
#undef GRID_BAR
}
__device__ __forceinline__ void mask_pos(int s, int& hw, int& bit) { const int j = s >> 5, w = s & 31, hi = (w >> 2) & 1; bit = (w & 3) | ((w >> 3) << 2); hw = (((j >> 1) * 2 + hi) * 2 + (j & 1)); }

__global__ void __launch_bounds__(64) nk_cumsum2(const float* logf, float* cum) {
    const int b = blockIdx.x >> 3, h = blockIdx.x & 7, l = threadIdx.x;
    const float* src = logf + (size_t)(b * S_ + 64 * l) * 8 + h;
    double s = 0.0;
    for (int i = 0; i < 64; ++i) s += (double)src[(size_t)i * 8];
    double incl = s;
    for (int o = 1; o < 64; o <<= 1) { const double v = __shfl_up(incl, o); if (l >= o) incl += v; }
    double run = incl - s;
    for (int i = 0; i < 64; ++i) { run += (double)src[(size_t)i * 8]; cum[(size_t)(b * S_ + 64 * l + i) * 8 + h] = (float)run; }
}

__global__ void __launch_bounds__(256) nk_select2(const f16* iqb, const f16* ikb, const float* iwb, unsigned short* mask) {
    __shared__ float iq[256]; __shared__ float iw[4]; __shared__ unsigned key[4096]; __shared__ unsigned hist[256]; __shared__ int sh_bin, sh_kk; __shared__ unsigned cnt[256]; __shared__ unsigned char sel[4096];
    const int t = blockIdx.x, b = blockIdx.y, tid = threadIdx.x, row = b * S_ + t, n = t + 1;
    unsigned short* mrow = mask + (size_t)row * 256;
    if (n <= 256) { for (int i = 0; i < 16; ++i) sel[tid * 16 + i] = (tid * 16 + i) < n ? 1 : 0; }
    else {
    iq[tid] = (float)iqb[(size_t)row * 256 + tid]; if (tid < 4) iw[tid] = iwb[(size_t)row * 4 + tid];
    __syncthreads();
#pragma unroll 1
    for (int s = tid; s < n; s += 256) {
        asm volatile("" ::: "memory");
        const f16* kr = ikb + (size_t)(b * S_ + s) * 64;
        float d[4] = {0.f, 0.f, 0.f, 0.f};
#pragma unroll
        for (int j = 0; j < 64; ++j) { const float kv = (float)kr[j];
#pragma unroll
            for (int h = 0; h < 4; ++h) d[h] += iq[h * 64 + j] * kv; }
        float sc = 0.f;
#pragma unroll
        for (int h = 0; h < 4; ++h) sc += fmaxf(d[h] * 0.125f, 0.f) * iw[h];
        key[s] = mono_key(sc);
    }
    __syncthreads();
    unsigned prefix = 0u, pmask = 0u; int kk = 256;
    for (int shift = 24; shift >= 0; shift -= 8) {
        hist[tid] = 0u; __syncthreads();
        for (int s = tid; s < n; s += 256) { const unsigned k = key[s]; if ((k & pmask) == prefix) atomicAdd(&hist[(k >> shift) & 255u], 1u); }
        __syncthreads();
        if (tid == 0) { int c = 0, bin = 255; while (bin > 0 && c + (int)hist[bin] < kk) { c += (int)hist[bin]; --bin; } sh_bin = bin; sh_kk = kk - c; }
        __syncthreads();
        prefix |= (unsigned)sh_bin << shift; pmask |= 255u << shift; kk = sh_kk;
        __syncthreads();
    }
    unsigned ceq = 0u;
    for (int i = 0; i < 16; ++i) { const int s = tid * 16 + i; if (s < n && key[s] == prefix) ++ceq; }
    cnt[tid] = ceq; __syncthreads();
    unsigned before = 0u; for (int j = 0; j < tid; ++j) before += cnt[j];
    for (int i = 0; i < 16; ++i) { const int s = tid * 16 + i; unsigned char v = 0; if (s < n) { const unsigned k = key[s];
        if (k > prefix) v = 1; else if (k == prefix) { if ((int)before < kk) v = 1; ++before; } } sel[s] = v; }
    }
    __syncthreads();
    { const int hw = tid, J = hw >> 2, hi = (hw >> 1) & 1, j = 2 * J + (hw & 1); unsigned bits = 0u;
      for (int r = 0; r < 16; ++r) { const int s = 32 * j + (r & 3) + 8 * (r >> 2) + 4 * hi; if (sel[s]) bits |= 1u << r; }
      mrow[hw] = (unsigned short)bits; }
}

template <int MODE> __global__ void __launch_bounds__(256) nk_attn2(const f16* Q, const f16* K, const f16* V, const float* cum, const unsigned short* mask, float* o, int ooff) {
    __shared__ float lg[4096]; __shared__ float qs[64]; __shared__ float red[256];
    const int t = blockIdx.x, h = blockIdx.y, b = blockIdx.z, tid = threadIdx.x, row = b * S_ + t, n = t + 1;
    if (tid < 64) qs[tid] = (float)Q[(size_t)row * 512 + h * 64 + tid];
    __syncthreads();
    const float cq = (MODE == 0) ? cum[(size_t)row * 8 + h] : 0.f;
    float mx = -INFINITY;
    for (int s = tid; s < n; s += 256) {
        const f16* kr = K + (size_t)(b * S_ + s) * 512 + h * 64;
        float d = 0.f;
#pragma unroll
        for (int j = 0; j < 64; ++j) d += qs[j] * (float)kr[j];
        d *= 0.6931471805599453f;
        if (MODE == 0) d += cq - cum[(size_t)(b * S_ + s) * 8 + h];
        else { int hw, bit; mask_pos(s, hw, bit); if (!((mask[(size_t)row * 256 + hw] >> bit) & 1u)) d = -INFINITY; }
        lg[s] = d; mx = fmaxf(mx, d);
    }
    __syncthreads();
    mx = block_max256(mx, red);
    float sum = 0.f;
    for (int s = tid; s < n; s += 256) { const float p = expf(lg[s] - mx); lg[s] = p; sum += p; }
    __syncthreads();
    sum = block_sum256(sum, red);
    const int d = tid & 63, g = tid >> 6; float acc = 0.f;
    for (int s = g; s < n; s += 4) acc += lg[s] * (float)V[(size_t)(b * S_ + s) * 512 + h * 64 + d];
    red[tid] = acc; __syncthreads();
    if (tid < 64) o[(size_t)row * D_ + ooff + h * 64 + tid] = (red[tid] + red[tid + 64] + red[tid + 128] + red[tid + 192]) / sum;
}

__global__ void __launch_bounds__(256) nk_o_bridge(const float* o, f16* O, float* ssq) {
    __shared__ float red[256];
    const int row = blockIdx.x, tid = threadIdx.x;
    float s = 0.f;
    for (int i = 0; i < 4; ++i) { const int c = tid * 4 + i; const f16 hv = (f16)o[(size_t)row * D_ + c]; O[(size_t)row * D_ + c] = hv; const float f = (float)hv; s += f * f; }
    red[tid] = s; __syncthreads();
    if (tid < 16) { float a = 0.f; for (int j = 0; j < 16; ++j) a += red[tid * 16 + j]; ssq[(size_t)tid * M_ + row] = a; }
}
static int fwd_grid() {
    static int grid = 0;
    if (grid == 0) {
        int dev = 0, cus = 0, per_cu = 0;
        if (hipGetDevice(&dev) != hipSuccess || hipDeviceGetAttribute(&cus, hipDeviceAttributeMultiprocessorCount, dev) != hipSuccess) { fprintf(stderr, "kernel_launch: device query failed\n"); grid = -1; return grid; }
        if (hipFuncSetAttribute((const void*)fwd, hipFuncAttributeMaxDynamicSharedMemorySize, LDS_BYTES) != hipSuccess) { fprintf(stderr, "kernel_launch: hipFuncSetAttribute failed\n"); grid = -1; return grid; }
        if (hipOccupancyMaxActiveBlocksPerMultiprocessor(&per_cu, (const void*)fwd, NTHR, LDS_BYTES) != hipSuccess || per_cu < 1) fprintf(stderr, "kernel_launch: occupancy query reports %d blocks per CU\n", per_cu);
        (void)hipGetLastError();
        grid = cus;
    }
    return grid;
}
static void launch_fwd(FArgs a, int lo, int hi, int li, int grid, hipStream_t stream) {
    a.ph_lo = lo; a.ph_hi = hi; a.li = li; a.pad = 0;
    hipLaunchKernelGGL(fwd, dim3(grid), dim3(NTHR), LDS_BYTES, stream, a);
}
static void fill_args(FArgs& a, void* const* d_in, void* d_out, unsigned char* ws) {
    memset(&a, 0, sizeof(a));
    for (int i = 0; i < 16; ++i) a.in[i] = (const float*)d_in[i];
    a.out = (float*)d_out; a.ctl = (unsigned*)(ws); a.mod = (float*)(ws + 1 * MiB); a.rope = (float*)(ws + 2 * MiB);
    a.win_t = (f16*)(ws + 4 * MiB); a.wout_t = (f16*)(ws + 11 * MiB); a.wgu_t = (f16*)(ws + 13 * MiB); a.wd_t = (f16*)(ws + 24 * MiB);
    a.iw = (float*)(ws + 30 * MiB); a.logf = (float*)(ws + 31 * MiB); a.mask = (unsigned*)(ws + 32 * MiB); a.ssq = (float*)(ws + 48 * MiB);
    a.iq = (f16*)(ws + 50 * MiB); a.ik = (f16*)(ws + 66 * MiB); a.h = (f16*)(ws + 70 * MiB); a.o = (f16*)(ws + 134 * MiB);
    a.qd = (f16*)(ws + 198 * MiB); a.kd = (f16*)(ws + 230 * MiB); a.vd = (f16*)(ws + 262 * MiB); a.qf = (f16*)(ws + 294 * MiB); a.kf = (f16*)(ws + 326 * MiB); a.vf = (f16*)(ws + 358 * MiB);
    a.ssq2 = (float*)(a.ctl + 131072); a.cb = (float*)(ws + 30 * MiB + 512 * 1024);
    a.act = (f16*)(ws + 198 * MiB);
}

extern "C" void kernel_launch(void* const* d_in, const int* in_sizes, int n_in, void* d_out, int out_size, void* d_ws, size_t ws_size, hipStream_t stream) {
    if (ws_size < 512 * MiB || n_in != 16 || out_size != M_ * D_) { fprintf(stderr, "kernel_launch: unexpected sizes ws %zu n_in %d out %d\n", ws_size, n_in, out_size); return; }
    const int grid = fwd_grid(); if (grid < 0) return;
    unsigned char* ws = (unsigned char*)d_ws; float* out = (float*)d_out;
    FArgs a; fill_args(a, d_in, d_out, ws);
    hipMemsetAsync(a.ctl, 0, 1 * MiB, stream);
#ifdef DUP_K
    launch_fwd(a, 0, DUP_K + 1, 0, grid, stream);
    launch_fwd(a, DUP_K, 11, 1, grid, stream);
#else
    launch_fwd(a, 0, 11, 0, grid, stream);
#endif
}
```
